# Optimizing an MI355X kernel written in HIP

```python
import jax, jax.numpy as jnp
from jax import lax
import numpy as np

D_MODEL = 1024
BATCH = 4
SEQ = 4096
DEPTH = 1

CONV_DIM = D_MODEL // 2
CONV_WIDTH = 3
RWKV_DIM = D_MODEL - CONV_DIM
HEAD_DIM = 64
RWKV_HEADS = RWKV_DIM // HEAD_DIM
DECAY_RANK = 64
ICLR_RANK = 64
GATE_RANK = 160
D_FF = 4 * D_MODEL
PLE_DIM = 256
CONV_COLS = 3 * CONV_DIM
RWKV_COLS = 3 * RWKV_DIM + DECAY_RANK + ICLR_RANK + GATE_RANK
IN_COLS = CONV_COLS + RWKV_COLS
RWKV_SPLITS = (RWKV_DIM, 2 * RWKV_DIM, 3 * RWKV_DIM, 3 * RWKV_DIM + DECAY_RANK, 3 * RWKV_DIM + DECAY_RANK + ICLR_RANK)
RMS_EPS = 1e-6
GN_EPS = 64e-5
L2_EPS = 1e-12

kernel_name = 'hybrid_shortconv_rwkv7_block'


def _rms_norm(h, g):
    hf = h.astype(jnp.float32)
    y = hf * lax.rsqrt(jnp.mean(hf * hf, axis=-1, keepdims=True) + RMS_EPS)
    return (y * g.astype(jnp.float32)).astype(h.dtype)


def _shift_one(u):
    return jnp.pad(u, ((0, 0), (1, 0), (0, 0)))[:, :-1]


def _short_gated_conv(cols, conv_w):
    gate_b, gate_c, hx = jnp.split(cols, 3, axis=-1)
    u = gate_c * hx
    t_len = u.shape[1]
    up = jnp.pad(u, ((0, 0), (CONV_WIDTH - 1, 0), (0, 0)))
    conv = up[:, 0:t_len] * conv_w[0]
    for j in range(1, CONV_WIDTH):
        conv = conv + up[:, j:j + t_len] * conv_w[j]
    return gate_b * conv


def _rwkv7_recurrence(r, w, k, v, a, b):
    bsz, _, n_heads, n = r.shape

    def step(s, inp):
        r_t, w_t, k_t, v_t, a_t, b_t = inp
        sa = jnp.einsum('bhvk,bhk->bhv', s, a_t)
        s = s * w_t[:, :, None, :] + sa[..., None] * b_t[:, :, None, :] + v_t[..., None] * k_t[:, :, None, :]
        return s, jnp.einsum('bhvk,bhk->bhv', s, r_t)

    xs = tuple(jnp.moveaxis(t, 1, 0) for t in (r, w, k, v, a, b))
    s0 = jnp.zeros((bsz, n_heads, n, n), jnp.float32)
    _, ys = lax.scan(step, s0, xs)
    return jnp.moveaxis(ys, 0, 1)


def _rwkv7_time_mix(cols, shift_mu, w_lora_up, w0, a_lora_up, a0, g_lora_up, k_k, k_a, r_k, ln_x_g, ln_x_b):
    f32 = jnp.float32
    bsz, t_len, _ = cols.shape
    u = cols + shift_mu * (_shift_one(cols) - cols)
    r, k, v, xw, xa, xg = jnp.split(u, RWKV_SPLITS, axis=-1)
    w_log = -jax.nn.softplus(-(w0 + jnp.tanh(xw) @ w_lora_up).astype(f32)) - 0.5
    decay = jnp.exp(-jnp.exp(w_log))
    iclr = jax.nn.sigmoid((a0 + xa @ a_lora_up).astype(f32))
    g = jax.nn.sigmoid(xg) @ g_lora_up

    def heads(t):
        return t.astype(f32).reshape(bsz, t_len, RWKV_HEADS, HEAD_DIM)

    kk = heads(k * k_k)
    kk = kk / jnp.maximum(jnp.sqrt(jnp.sum(kk * kk, axis=-1, keepdims=True)), L2_EPS)
    k_h = heads(k.astype(f32) * (1.0 + (iclr - 1.0) * k_a.astype(f32)))
    r_h, v_h, a_h = heads(r), heads(v), heads(iclr)
    y = _rwkv7_recurrence(r_h, heads(decay), k_h, v_h, -kk, kk * a_h)
    mu = jnp.mean(y, axis=-1, keepdims=True)
    var = jnp.mean(jnp.square(y - mu), axis=-1, keepdims=True)
    y = ((y - mu) * lax.rsqrt(var + GN_EPS)).reshape(bsz, t_len, RWKV_DIM)
    y = y * ln_x_g.astype(f32) + ln_x_b.astype(f32)
    bonus = jnp.sum(r_h * k_h * r_k.astype(f32), axis=-1, keepdims=True) * v_h
    y = (y + bonus.reshape(bsz, t_len, RWKV_DIM)) * g.astype(f32)
    return y.astype(cols.dtype)


def setup_inputs(seed: int = 0) -> dict:
    key = jax.random.key(seed)
    ks = jax.random.split(key, 26)
    f32 = jnp.float32
    L, D = DEPTH, D_MODEL

    def nrm(k, shape, scale):
        return jax.random.normal(k, shape, f32) * scale

    return {
        'x': nrm(ks[0], (BATCH, SEQ, D), 1.0),
        'p': nrm(ks[1], (DEPTH, BATCH, SEQ, PLE_DIM), 1.0),
        'norm_mix_g': 1.0 + nrm(ks[2], (L, D), 0.02),
        'w_in': nrm(ks[3], (L, D, IN_COLS), D ** -0.5),
        'conv_w': nrm(ks[4], (L, CONV_WIDTH, CONV_DIM), CONV_WIDTH ** -0.5),
        'shift_mu': jax.random.uniform(ks[5], (L, RWKV_COLS), f32),
        'w_lora_up': nrm(ks[6], (L, DECAY_RANK, RWKV_DIM), DECAY_RANK ** -0.5),
        'w0': jax.random.uniform(ks[7], (L, RWKV_DIM), f32, -4.0, 1.0),
        'a_lora_up': nrm(ks[8], (L, ICLR_RANK, RWKV_DIM), ICLR_RANK ** -0.5),
        'a0': nrm(ks[9], (L, RWKV_DIM), 0.1),
        'g_lora_up': nrm(ks[10], (L, GATE_RANK, RWKV_DIM), GATE_RANK ** -0.5),
        'k_k': 0.85 + nrm(ks[11], (L, RWKV_DIM), 0.02),
        'k_a': 1.0 + nrm(ks[12], (L, RWKV_DIM), 0.02),
        'r_k': nrm(ks[13], (L, RWKV_HEADS, HEAD_DIM), 0.1),
        'ln_x_g': 1.0 + nrm(ks[14], (L, RWKV_DIM), 0.02),
        'ln_x_b': nrm(ks[15], (L, RWKV_DIM), 0.02),
        'w_out': nrm(ks[16], (L, D, D), D ** -0.5),
        'norm_mlp_g': 1.0 + nrm(ks[17], (L, D), 0.02),
        'w_up': nrm(ks[18], (L, D, D_FF), D ** -0.5),
        'w_down': nrm(ks[19], (L, D_FF, D), D_FF ** -0.5),
        'norm_ple_g': 1.0 + nrm(ks[20], (L, D), 0.02),
        'w_ple_gate': nrm(ks[21], (L, D, D), D ** -0.5),
        'w_ple_proj': nrm(ks[22], (L, PLE_DIM, D), PLE_DIM ** -0.5),
        'norm_final_g': 1.0 + nrm(ks[23], (D,), 0.02),
    }


def reference(x, p, norm_mix_g, w_in, conv_w, shift_mu, w_lora_up, w0, a_lora_up, a0, g_lora_up, k_k, k_a, r_k, ln_x_g, ln_x_b, w_out, norm_mlp_g, w_up, w_down, norm_ple_g, w_ple_gate, w_ple_proj, norm_final_g):
    h = x
    for i in range(DEPTH):
        proj = _rms_norm(h, norm_mix_g[i]) @ w_in[i]
        y_conv = _short_gated_conv(proj[..., :CONV_COLS], conv_w[i])
        y_rwkv = _rwkv7_time_mix(proj[..., CONV_COLS:], shift_mu[i], w_lora_up[i], w0[i], a_lora_up[i], a0[i], g_lora_up[i], k_k[i], k_a[i], r_k[i], ln_x_g[i], ln_x_b[i])
        h = h + jnp.concatenate([y_conv, y_rwkv], axis=-1) @ w_out[i]
        hidden = jax.nn.relu(_rms_norm(h, norm_mlp_g[i]) @ w_up[i])
        h = h + jnp.square(hidden) @ w_down[i]
        gate = jax.nn.sigmoid(_rms_norm(h, norm_ple_g[i]) @ w_ple_gate[i])
        h = h + gate * (p[i] @ w_ple_proj[i])
    return _rms_norm(h, norm_final_g)
```

```cpp
#include <hip/hip_runtime.h>
#include <cstdio>
#include <cstdint>

namespace pg8 {
#define PG8_LAS __attribute__((address_space(3)))
typedef unsigned short bf16_t;
typedef short bf16x8 __attribute__((ext_vector_type(8)));
typedef float f32x4 __attribute__((ext_vector_type(4)));
typedef unsigned u32x4 __attribute__((ext_vector_type(4)));
constexpr int BM = 256, BK = 64, HALF = 128, HTB = HALF * BK * 2  , STAGE_BYTES = 8 * HTB, NXCD = 8, WGM = 8;

__host__ __device__ __forceinline__ int lds_byte(int r, int c) { const int st = (r >> 4) * 2 + (c >> 5), rr = r & 15, cc = c & 31, ob = rr * 64 + cc * 2; return st * 1024 + (ob ^ (((ob >> 9) & 1) << 5)); }
__host__ __device__ __forceinline__ void stage_rc(int b, int& R, int& C) { const int st = b / 1024, sb = b % 1024, swz = sb ^ (((sb >> 9) & 1) << 5); R = (st >> 1) * 16 + swz / 64; C = (st & 1) * 32 + (swz % 64) / 2; }
__host__ __device__ __forceinline__ int perm32(int rho) { const int n = rho >> 4, i = rho & 15; return 8 * (i >> 2) + 4 * n + (i & 3); }

struct Unit { int pm, pn; };
struct Gemm { const bf16_t* A; const bf16_t* Bt; int M, N, K; };

struct StaticOrder {
    int nM, nN, nwg, G, c;
    __host__ __device__ void init(int M, int N, int G_, int c_) { nM = M / BM; nN = N / BM; nwg = nM * nN; G = G_; c = c_; }
    __host__ __device__ bool next(int i, Unit& u) const {
        const long L = (long)i * G + c; if (L >= nwg) return false;
        int wgid = (int)L; { const int q = nwg / NXCD, r = nwg % NXCD, xcd = wgid % NXCD, off = wgid / NXCD; wgid = (xcd < r ? xcd * (q + 1) : r * (q + 1) + (xcd - r) * q) + off; }
        const int nig = WGM * nN, gid = wgid / nig, fm = gid * WGM, gsz = (nM - fm) < WGM ? (nM - fm) : WGM;
        u.pm = fm + ((wgid % nig) % gsz); u.pn = (wgid % nig) / gsz; return true;
    }
    __device__ __forceinline__ void a_ready(const Unit&) const {}
    __device__ __forceinline__ void done(const Unit&) const {}
};

__device__ __forceinline__ unsigned cvt_pk_bf16(float lo, float hi) { unsigned r; asm volatile("v_cvt_pk_bf16_f32 %0, %1, %2" : "=v"(r) : "v"(lo), "v"(hi)); return r; }
typedef float f32x2 __attribute__((ext_vector_type(2)));

typedef unsigned u32x2 __attribute__((ext_vector_type(2)));
struct EpiBf16G {
    static constexpr bool PERM = true, AFTER_DRAIN = false;
    bf16_t* O; int ldc; int ncols;
    __device__ __forceinline__ void operator()(const f32x4 (&acc)[2][2][4][2], const Unit& u, int wr, int wc, int fr, int fq) const {
        const int row0 = u.pm * BM + wr * 64 + fr, col0 = u.pn * BM + wc * 32 + 8 * fq;
#pragma unroll
        for (int ai = 0; ai < 2; ++ai)
#pragma unroll
            for (int m = 0; m < 4; ++m) { bf16_t* rowp = O + (size_t)(row0 + ai * HALF + m * 16) * ldc + col0;
#pragma unroll
                for (int bj = 0; bj < 2; ++bj) { if (col0 + bj * HALF < ncols) { const f32x4 v0 = acc[ai][bj][m][0], v1 = acc[ai][bj][m][1];
                    u32x4 w; w.x = cvt_pk_bf16(v0[0], v0[1]); w.y = cvt_pk_bf16(v0[2], v0[3]); w.z = cvt_pk_bf16(v1[0], v1[1]); w.w = cvt_pk_bf16(v1[2], v1[3]);
                    *(u32x4*)(rowp + bj * HALF) = w; } } }
    }
};
struct EpiSqRelu {
    static constexpr bool PERM = true, AFTER_DRAIN = false;
    bf16_t* O; int ldc; const float* ssq; float inv_n, eps;
    __device__ __forceinline__ void operator()(const f32x4 (&acc)[2][2][4][2], const Unit& u, int wr, int wc, int fr, int fq) const {
        const int row0 = u.pm * BM + wr * 64 + fr, col0 = u.pn * BM + wc * 32 + 8 * fq;
#pragma unroll
        for (int ai = 0; ai < 2; ++ai)
#pragma unroll
            for (int m = 0; m < 4; ++m) { const int row = row0 + ai * HALF + m * 16; bf16_t* rowp = O + (size_t)row * ldc + col0;
                const f32x4 s4 = *(const f32x4*)(ssq + (size_t)row * 4); const float rs = rsqrtf(((s4[0] + s4[1]) + (s4[2] + s4[3])) * inv_n + eps);
#pragma unroll
                for (int bj = 0; bj < 2; ++bj) { f32x4 v0 = acc[ai][bj][m][0] * rs, v1 = acc[ai][bj][m][1] * rs;
#pragma unroll
                    for (int e = 0; e < 4; ++e) { const float a = fmaxf(v0[e], 0.f), b = fmaxf(v1[e], 0.f); v0[e] = a * a; v1[e] = b * b; }
                    u32x4 w; w.x = cvt_pk_bf16(v0[0], v0[1]); w.y = cvt_pk_bf16(v0[2], v0[3]); w.z = cvt_pk_bf16(v1[0], v1[1]); w.w = cvt_pk_bf16(v1[2], v1[3]);
                    *(u32x4*)(rowp + bj * HALF) = w; } }
    }
};
struct EpiRes {
    static constexpr bool PERM = false, AFTER_DRAIN = true;
    const float* base; float* out; bf16_t* hb; float* ssq; int ldc;
    __device__ __forceinline__ void fused(f32x4 (&acc)[2][2][4][2], const Unit& u, int wr, int wc, int fr, int fq, PG8_LAS unsigned char* lds, int wid, int lane) const {
        PG8_LAS float* P = (PG8_LAS float*)lds;
        const int col0 = u.pn * BM + wc * 32 + 4 * fq;
#pragma unroll
        for (int ai = 0; ai < 2; ++ai)
#pragma unroll
            for (int m = 0; m < 4; ++m) { const int r = ai * HALF + wr * 64 + m * 16 + fr; const size_t off = (size_t)(u.pm * BM + r) * ldc + col0; float ss = 0.f;
#pragma unroll
                for (int bj = 0; bj < 2; ++bj)
#pragma unroll
                    for (int n = 0; n < 2; ++n) { const size_t o2 = off + bj * HALF + n * 16; const f32x4 bs = *(const f32x4*)(base + o2); const f32x4 h = bs + acc[ai][bj][m][n];
                        *(f32x4*)(out + o2) = h; ss += (h[0] * h[0] + h[1] * h[1]) + (h[2] * h[2] + h[3] * h[3]);
                        u32x2 w; w.x = cvt_pk_bf16(h[0], h[1]); w.y = cvt_pk_bf16(h[2], h[3]); *(u32x2*)(hb + o2) = w; }
                ss += __shfl_xor(ss, 16); ss += __shfl_xor(ss, 32);
                if (fq == 0) P[r * 4 + wc] = ss;
                asm volatile("" ::: "memory"); }
        asm volatile("s_waitcnt lgkmcnt(0)" ::: "memory"); __builtin_amdgcn_s_barrier(); asm volatile("" ::: "memory");
        const int tid = wid * 64 + lane;
        if (tid < 256) { const f32x4 p = *(const PG8_LAS f32x4*)(P + tid * 4); ssq[(size_t)(u.pm * BM + tid) * 4 + u.pn] = (p[0] + p[1]) + (p[2] + p[3]); }
        asm volatile("s_waitcnt lgkmcnt(0)" ::: "memory"); __builtin_amdgcn_s_barrier(); asm volatile("" ::: "memory");
    }
};
struct EpiGate {
    static constexpr bool PERM = false, AFTER_DRAIN = true;
    float* io; const bf16_t* ple; const float* ssq_in; float* ssq_out; int ldc; float inv_n, eps;
    __device__ __forceinline__ void fused(f32x4 (&acc)[2][2][4][2], const Unit& u, int wr, int wc, int fr, int fq, PG8_LAS unsigned char* lds, int wid, int lane) const {
        PG8_LAS float* P = (PG8_LAS float*)lds;
        const int col0 = u.pn * BM + wc * 32 + 4 * fq;
#pragma unroll
        for (int ai = 0; ai < 2; ++ai)
#pragma unroll
            for (int m = 0; m < 4; ++m) { const int r = ai * HALF + wr * 64 + m * 16 + fr; const size_t off = (size_t)(u.pm * BM + r) * ldc + col0; float ss = 0.f;
                const f32x4 s4 = *(const f32x4*)(ssq_in + (size_t)(u.pm * BM + r) * 4); const float rs = rsqrtf(((s4[0] + s4[1]) + (s4[2] + s4[3])) * inv_n + eps);
#pragma unroll
                for (int bj = 0; bj < 2; ++bj)
#pragma unroll
                    for (int n = 0; n < 2; ++n) { const size_t o2 = off + bj * HALF + n * 16; const f32x4 h2 = *(const f32x4*)(io + o2); const u32x2 pw = *(const u32x2*)(ple + o2);
                        f32x4 pl; pl[0] = __uint_as_float(pw.x << 16); pl[1] = __uint_as_float(pw.x & 0xffff0000u); pl[2] = __uint_as_float(pw.y << 16); pl[3] = __uint_as_float(pw.y & 0xffff0000u);
                        f32x4 h; const f32x4 a = acc[ai][bj][m][n] * rs;
#pragma unroll
                        for (int e = 0; e < 4; ++e) { const float g = 1.0f / (1.0f + __expf(-a[e])); h[e] = h2[e] + g * pl[e]; }
                        *(f32x4*)(io + o2) = h; ss += (h[0] * h[0] + h[1] * h[1]) + (h[2] * h[2] + h[3] * h[3]); }
                ss += __shfl_xor(ss, 16); ss += __shfl_xor(ss, 32);
                if (fq == 0) P[r * 4 + wc] = ss;
                asm volatile("" ::: "memory"); }
        asm volatile("s_waitcnt lgkmcnt(0)" ::: "memory"); __builtin_amdgcn_s_barrier(); asm volatile("" ::: "memory");
        const int tid = wid * 64 + lane;
        if (tid < 256) { const f32x4 p = *(const PG8_LAS f32x4*)(P + tid * 4); ssq_out[(size_t)(u.pm * BM + tid) * 4 + u.pn] = (p[0] + p[1]) + (p[2] + p[3]); }
        asm volatile("s_waitcnt lgkmcnt(0)" ::: "memory"); __builtin_amdgcn_s_barrier(); asm volatile("" ::: "memory");
    }
};


template <class Epi, class Sched, bool ALIGN_EPI = false, bool SP2 = false>
__device__ __forceinline__ void gemm_phase(PG8_LAS unsigned char* lds, const Gemm g, const Sched& S, const Epi& E) {
    const int tid = threadIdx.x, wid = __builtin_amdgcn_readfirstlane(tid >> 6), lane = tid & 63, wr = wid >> 2, wc = wid & 3, fr = lane & 15, fq = lane >> 4;
    const int K = g.K, nt = K / BK;
    unsigned voffA[2], voffB[2];
#pragma unroll
    for (int i = 0; i < 2; ++i) { int R, C; stage_rc(tid * 16 + i * 8192, R, C); const int Rb = Epi::PERM ? ((R & ~31) + perm32(R & 31)) : R;
        voffA[i] = (unsigned)(R * K + C) * 2u; voffB[i] = (unsigned)(Rb * K + C) * 2u; }
    const size_t kstep = (size_t)(BK * 2);
    const size_t hstep = (size_t)HALF * K * 2;
    const size_t tstep = 2 * hstep;
    const unsigned ldsw = (unsigned)wid * 1024u;
    const int aoff = lds_byte(wr * 64 + fr, fq * 8), boff = lds_byte(wc * 32 + fr, fq * 8);
#define PG8_SA(b, h) (((b) * 2 + (h)) * HTB)
#define PG8_SB(b, h) ((4 + (b) * 2 + (h)) * HTB)
#define PG8_STAGE(bufoff, gbase, voff) do { _Pragma("unroll") for (int _i = 0; _i < 2; ++_i) \
        __builtin_amdgcn_global_load_lds((const unsigned*)((const char*)(gbase) + (voff)[_i]), (PG8_LAS unsigned*)(lds + (bufoff) + ldsw + _i * 8192), 16, 0, 0); } while (0)
#define PG8_LDA(dst, b, h) do { _Pragma("unroll") for (int m = 0; m < 4; ++m) _Pragma("unroll") for (int k = 0; k < 2; ++k) dst[m][k] = *(const PG8_LAS bf16x8*)(lds + PG8_SA(b, h) + aoff + m * 2048 + k * 1024); } while (0)
#define PG8_LDB(dst, b, h) do { _Pragma("unroll") for (int n = 0; n < 2; ++n) _Pragma("unroll") for (int k = 0; k < 2; ++k) dst[n][k] = *(const PG8_LAS bf16x8*)(lds + PG8_SB(b, h) + boff + n * 2048 + k * 1024); } while (0)
#define PG8_MMA(ai, bj, At, Bt) do { __builtin_amdgcn_s_setprio(1); _Pragma("unroll") for (int m = 0; m < 4; ++m) _Pragma("unroll") for (int n = 0; n < 2; ++n) _Pragma("unroll") for (int k = 0; k < 2; ++k) \
        acc[ai][bj][m][n] = __builtin_amdgcn_mfma_f32_16x16x32_bf16(Bt[n][k], At[m][k], acc[ai][bj][m][n], 0, 0, 0); __builtin_amdgcn_s_setprio(0); } while (0)
#define PG8_WAIT_V(n) asm volatile("s_waitcnt vmcnt(" #n ")" ::: "memory")
#define PG8_WAIT_L(n) asm volatile("s_waitcnt lgkmcnt(" #n ")" ::: "memory")
#define PG8_BAR __builtin_amdgcn_s_barrier()
#define PG8_SCHED __builtin_amdgcn_sched_barrier(0)
    Unit cur, nxt; int ui = 0;
    if (!S.next(0, cur)) return;
    f32x4 acc[2][2][4][2];
#pragma unroll
    for (int a = 0; a < 2; ++a)
#pragma unroll
        for (int b = 0; b < 2; ++b)
#pragma unroll
            for (int m = 0; m < 4; ++m)
#pragma unroll
                for (int n = 0; n < 2; ++n) acc[a][b][m][n] = (f32x4){0.f, 0.f, 0.f, 0.f};
    bf16x8 At[4][2], B0[2][2], B1[2][2];
    const char* cA = (const char*)g.A + (size_t)cur.pm * tstep; const char* cB = (const char*)g.Bt + (size_t)cur.pn * tstep;
    S.a_ready(cur);
    if constexpr (SP2) {
        PG8_STAGE(PG8_SB(0, 0), cB, voffB); PG8_STAGE(PG8_SB(0, 1), cB + hstep, voffB); PG8_STAGE(PG8_SA(0, 0), cA, voffA); PG8_STAGE(PG8_SA(0, 1), cA + hstep, voffA);
        if (wr == 1) PG8_BAR;
        PG8_WAIT_V(2); PG8_BAR;
        PG8_STAGE(PG8_SB(1, 0), cB + kstep, voffB); PG8_STAGE(PG8_SA(1, 0), cA + kstep, voffA); PG8_STAGE(PG8_SB(1, 1), cB + hstep + kstep, voffB);
        PG8_WAIT_V(6); PG8_BAR;
    } else {
        PG8_STAGE(PG8_SB(0, 0), cB, voffB); PG8_STAGE(PG8_SA(0, 0), cA, voffA); PG8_STAGE(PG8_SB(0, 1), cB + hstep, voffB); PG8_STAGE(PG8_SA(0, 1), cA + hstep, voffA);
        if (wr == 1) PG8_BAR;
        PG8_WAIT_V(4); PG8_BAR;
        PG8_STAGE(PG8_SB(1, 0), cB + kstep, voffB); PG8_STAGE(PG8_SA(1, 0), cA + kstep, voffA); PG8_STAGE(PG8_SB(1, 1), cB + hstep + kstep, voffB);
        PG8_WAIT_V(6); PG8_BAR;
    }
    for (;;) {
        const bool has_next = S.next(ui + 1, nxt);
        const char* nA = has_next ? (const char*)g.A + (size_t)nxt.pm * tstep : cA; const char* nB = has_next ? (const char*)g.Bt + (size_t)nxt.pn * tstep : cB;
        for (int t = 0; t < nt; t += 2) {
            const bool last = (t == nt - 2);
            const char* a1 = cA + (size_t)(t + 1) * kstep;
            const char* a2 = last ? nA : cA + (size_t)(t + 2) * kstep; const char* b2 = last ? nB : cB + (size_t)(t + 2) * kstep;
            const char* a3 = a2 + kstep; const char* b3 = b2 + kstep;
            if (last && has_next) S.a_ready(nxt);
            if constexpr (SP2) {
            PG8_LDB(B0, 0, 0); PG8_LDB(B1, 0, 1); PG8_SCHED; PG8_LDA(At, 0, 0); PG8_STAGE(PG8_SA(1, 1), a1 + hstep, voffA);
            PG8_WAIT_V(8); PG8_WAIT_L(0); PG8_BAR; PG8_MMA(0, 0, At, B0); PG8_MMA(0, 1, At, B1); PG8_BAR; PG8_SCHED;
            PG8_LDA(At, 0, 1); PG8_STAGE(PG8_SB(0, 0), b2, voffB); PG8_STAGE(PG8_SB(0, 1), b2 + hstep, voffB); PG8_STAGE(PG8_SA(0, 0), a2, voffA);
            PG8_WAIT_V(8); PG8_WAIT_L(0); PG8_BAR; PG8_MMA(1, 0, At, B0); PG8_MMA(1, 1, At, B1); PG8_BAR; PG8_SCHED;
            PG8_LDB(B0, 1, 0); PG8_LDB(B1, 1, 1); PG8_SCHED; PG8_LDA(At, 1, 0); PG8_STAGE(PG8_SA(0, 1), a2 + hstep, voffA);
            PG8_WAIT_V(8); PG8_WAIT_L(0); PG8_BAR; PG8_MMA(0, 0, At, B0); PG8_MMA(0, 1, At, B1); PG8_BAR; PG8_SCHED;
            PG8_LDA(At, 1, 1); PG8_STAGE(PG8_SB(1, 0), b3, voffB); PG8_STAGE(PG8_SB(1, 1), b3 + hstep, voffB); PG8_STAGE(PG8_SA(1, 0), a3, voffA);
            PG8_WAIT_V(8); PG8_WAIT_L(0); PG8_BAR; PG8_MMA(1, 0, At, B0); PG8_MMA(1, 1, At, B1); PG8_BAR; PG8_SCHED;
            } else {
            PG8_LDB(B0, 0, 0); PG8_SCHED; PG8_LDA(At, 0, 0); PG8_STAGE(PG8_SA(1, 1), a1 + hstep, voffA);
            PG8_WAIT_L(8); PG8_BAR; PG8_WAIT_L(0); PG8_MMA(0, 0, At, B0); PG8_BAR; PG8_SCHED;
            PG8_LDB(B1, 0, 1); PG8_STAGE(PG8_SB(0, 0), b2, voffB);
            PG8_BAR; PG8_WAIT_L(0); PG8_MMA(0, 1, At, B1); PG8_BAR;
            PG8_LDA(At, 0, 1); PG8_STAGE(PG8_SA(0, 0), a2, voffA);
            PG8_BAR; PG8_WAIT_L(0); PG8_MMA(1, 0, At, B0); PG8_BAR; PG8_SCHED;
            PG8_STAGE(PG8_SB(0, 1), b2 + hstep, voffB);
            PG8_WAIT_V(6); PG8_BAR; PG8_MMA(1, 1, At, B1); PG8_BAR;
            PG8_LDB(B0, 1, 0); PG8_SCHED; PG8_LDA(At, 1, 0); PG8_STAGE(PG8_SA(0, 1), a2 + hstep, voffA);
            PG8_WAIT_L(8); PG8_BAR; PG8_WAIT_L(0); PG8_MMA(0, 0, At, B0); PG8_BAR; PG8_SCHED;
            PG8_LDB(B1, 1, 1); PG8_STAGE(PG8_SB(1, 0), b3, voffB);
            PG8_BAR; PG8_WAIT_L(0); PG8_MMA(0, 1, At, B1); PG8_BAR;
            PG8_LDA(At, 1, 1); PG8_STAGE(PG8_SA(1, 0), a3, voffA);
            PG8_BAR; PG8_WAIT_L(0); PG8_MMA(1, 0, At, B0); PG8_BAR; PG8_SCHED;
            PG8_STAGE(PG8_SB(1, 1), b3 + hstep, voffB);
            PG8_WAIT_V(6); PG8_BAR; PG8_MMA(1, 1, At, B1); PG8_BAR;
            }
        }
        if constexpr (ALIGN_EPI) { if (wr == 0) PG8_BAR; }
        if constexpr (!Epi::AFTER_DRAIN) { E(acc, cur, wr, wc, fr, fq); S.done(cur); }
        if (!has_next) break;
#pragma unroll
        for (int a = 0; a < 2; ++a)
#pragma unroll
            for (int b = 0; b < 2; ++b)
#pragma unroll
                for (int m = 0; m < 4; ++m)
#pragma unroll
                    for (int n = 0; n < 2; ++n) acc[a][b][m][n] = (f32x4){0.f, 0.f, 0.f, 0.f};
        cur = nxt; cA = nA; cB = nB; ++ui;
        if constexpr (ALIGN_EPI) { if (wr == 1) PG8_BAR; }
    }
    PG8_WAIT_V(0);
    if constexpr (!ALIGN_EPI) { if (wr == 0) PG8_BAR; }
    PG8_BAR;
    if constexpr (Epi::AFTER_DRAIN) { E.fused(acc, cur, wr, wc, fr, fq, lds, wid, lane); S.done(cur); }
#undef PG8_SA
#undef PG8_SB
#undef PG8_STAGE
#undef PG8_LDA
#undef PG8_LDB
#undef PG8_MMA
#undef PG8_WAIT_V
#undef PG8_WAIT_L
#undef PG8_BAR
#undef PG8_SCHED
}
}

#ifndef PG8_SP2
#define PG8_SP2 true
#endif
#ifndef PG8_ALIGN
#define PG8_ALIGN true
#endif

constexpr int NWAVES = 8;
#ifndef MK_N_LAUNCHES
#define MK_N_LAUNCHES 1
#endif
constexpr int N_LAUNCHES = MK_N_LAUNCHES;

constexpr int BATCH = 4, T = 4096, D = 1024, FF = 4096, PLE = 256;
constexpr int M = BATCH * T;
constexpr int CONVD = 512, RWD = 512, NH = 8, HD = 64, RANK_W = 64, RANK_A = 64, RANK_G = 160;
constexpr int CONV_COLS = 3 * CONVD;
constexpr int RW_COLS = 3 * RWD + RANK_W + RANK_A + RANK_G;
constexpr int IN_COLS = CONV_COLS + RW_COLS;
constexpr int IN_PAD = 3584;
constexpr int PROJ_LD = IN_COLS;
constexpr int C_R = CONV_COLS, C_K = CONV_COLS + RWD, C_V = CONV_COLS + 2 * RWD, C_XW = CONV_COLS + 3 * RWD, C_XA = C_XW + RANK_W, C_XG = C_XA + RANK_A;
constexpr float RMS_EPS = 1e-6f, GN_EPS = 64e-5f, L2_EPS = 1e-12f;
constexpr int CH = 64, NCH = T / CH;

constexpr size_t MiB = 1u << 20;
constexpr size_t WS_CTL = 0, CTL_ZERO_BYTES = 64 * 1024;
constexpr size_t WS_WIN = 1 * MiB, WS_WOUT = 8 * MiB, WS_WUP = 10 * MiB, WS_WDN = 18 * MiB, WS_WG = 26 * MiB, WS_WPLE = 28 * MiB;
constexpr size_t WS_WL = 28 * MiB + 512 * 1024, WS_AL = WS_WL + 64 * 1024, WS_GL = WS_AL + 64 * 1024;
constexpr size_t WS_SSQ1 = 29 * MiB, WS_SSQ2 = WS_SSQ1 + 256 * 1024, WS_SSQ3 = WS_SSQ2 + 256 * 1024;
constexpr size_t WS_CB = 30 * MiB;
constexpr size_t WS_PB = 31 * MiB;
constexpr size_t WS_ABUF = 39 * MiB;
constexpr size_t WS_PLE = 71 * MiB;
constexpr size_t WS_MIX = 103 * MiB;
constexpr size_t WS_PROJ = 135 * MiB;
constexpr size_t WS_HSQ = 128 * MiB;
constexpr size_t WS_SB = 240 * MiB;
constexpr size_t WS_END = 256 * MiB;
static_assert(WS_PROJ + (size_t)M * PROJ_LD * 2 <= WS_SB && WS_HSQ + (size_t)M * FF * 2 <= WS_END && WS_GL + 512 * 160 * 2 <= WS_SSQ1, "d_ws map");
constexpr int CW_BAR = 1024;

constexpr int SLOT = 9216, NSLOT = 16, MLD = 72;
constexpr int RING_BYTES = 131072;
constexpr int LDSCTL_OFF = SLOT * NSLOT;
constexpr int LDS_BYTES = LDSCTL_OFF + 1024;

#define GAS __attribute__((address_space(1)))
#define LAS __attribute__((address_space(3)))
#define DI __device__ __forceinline__
typedef unsigned short bf16;
typedef unsigned v4u __attribute__((ext_vector_type(4)));
typedef unsigned v2u __attribute__((ext_vector_type(2)));
typedef float f32x4 __attribute__((ext_vector_type(4)));
typedef short bf16x8 __attribute__((ext_vector_type(8)));
typedef GAS unsigned gu32;
#define RLX_AGENT __ATOMIC_RELAXED, __HIP_MEMORY_SCOPE_AGENT
#define LDS_WAIT() asm volatile("s_waitcnt lgkmcnt(0)" ::: "memory")
#define VM_WAIT() asm volatile("s_waitcnt vmcnt(0)" ::: "memory")
DI unsigned f2bf(float f) { unsigned u = __builtin_bit_cast(unsigned, f); return (u + 0x7fffu + ((u >> 16) & 1u)) >> 16; }
DI unsigned pk2(float lo, float hi) { return f2bf(lo) | (f2bf(hi) << 16); }
DI float bflo(unsigned w) { return __uint_as_float(w << 16); }
DI float bfhi(unsigned w) { return __uint_as_float(w & 0xffff0000u); }
DI void unpack8(const v4u w, float (&o)[8]) { o[0] = bflo(w.x); o[1] = bfhi(w.x); o[2] = bflo(w.y); o[3] = bfhi(w.y); o[4] = bflo(w.z); o[5] = bfhi(w.z); o[6] = bflo(w.w); o[7] = bfhi(w.w); }
DI v4u pack8(const float (&v)[8]) { v4u w; w.x = pk2(v[0], v[1]); w.y = pk2(v[2], v[3]); w.z = pk2(v[4], v[5]); w.w = pk2(v[6], v[7]); return w; }
DI float sigmoidf_(float x) { return 1.0f / (1.0f + __expf(-x)); }
DI float red8(float v) { v += __shfl_xor(v, 1); v += __shfl_xor(v, 2); v += __shfl_xor(v, 4); return v; }


#define XB_TMO      128
#define XB_XCNT(j)  (256  + 64 * (j))
#define XB_XSUB(j)  (1280 + 64 * (j))
#define XB_XGEN(j)  (2304 + 64 * (j))
#define XB_TOP      3328
#define XB_TOPGEN   3392
#define XCD_BAR_WORDS 3456
#define XB_SPIN_CAP (1u << 18)

__device__ __forceinline__ unsigned xb_ld(unsigned* p)              { return __hip_atomic_load(p, __ATOMIC_RELAXED, __HIP_MEMORY_SCOPE_AGENT); }
__device__ __forceinline__ unsigned xb_add(unsigned* p, unsigned v) { return __hip_atomic_fetch_add(p, v, __ATOMIC_RELAXED, __HIP_MEMORY_SCOPE_AGENT); }
__device__ __forceinline__ unsigned xb_xcc_id() { return (unsigned)__builtin_amdgcn_s_getreg((3 << 11) | 20) & 0xFu; }
#define XB_SPIN(cond, bar) do { unsigned _sp = 0; while (cond) { __builtin_amdgcn_s_sleep(1); \
    if ((++_sp & 255u) == 0u) { if (xb_ld(&(bar)[XB_TMO])) break; if (_sp > XB_SPIN_CAP) { atomicAdd(&(bar)[XB_TMO], 1u); break; } } } } while (0)

struct XcdBarrier {
    unsigned* bar; unsigned x;
    volatile LAS unsigned* st;
};

__device__ __forceinline__ XcdBarrier xcd_barrier_post(unsigned* bar, volatile LAS unsigned* st) {
    XcdBarrier b; b.bar = bar; b.x = xb_xcc_id(); b.st = st;
    if (threadIdx.x == 0) (void)xb_add(&bar[XB_XCNT(b.x)], 1u);
    return b;
}
__device__ __forceinline__ void xcd_barrier_complete(unsigned* bar, unsigned x, unsigned& nloc, unsigned& nx) {
    const unsigned G = gridDim.x * gridDim.y * gridDim.z;
    unsigned sum, cnt, mine, sp = 0u;
    for (;;) {
        sum = 0u; cnt = 0u; mine = 0u;
#pragma unroll
        for (unsigned j = 0; j < 16; ++j) { const unsigned c = xb_ld(&bar[XB_XCNT(j)]); sum += c; cnt += (c > 0u) ? 1u : 0u; mine = (j == x) ? c : mine; }
        if (sum == G) break;
        __builtin_amdgcn_s_sleep(1);
        if ((++sp & 255u) == 0u) { if (xb_ld(&bar[XB_TMO])) break; if (sp > XB_SPIN_CAP) { atomicAdd(&bar[XB_TMO], 1u); break; } }
    }
    nloc = mine > 0u ? mine : 1u; nx = cnt > 0u ? cnt : 1u;
}

__device__ __forceinline__ void xcd_barrier(const XcdBarrier& b) {
    asm volatile("s_waitcnt vmcnt(0)" ::: "memory");
    __syncthreads();
    if (threadIdx.x == 0) {
        unsigned* bar = b.bar;
        __builtin_amdgcn_s_waitcnt(0);
        unsigned nloc = b.st[0], nx = b.st[1];
        if (nloc == 0u) { xcd_barrier_complete(bar, b.x, nloc, nx); b.st[0] = nloc; b.st[1] = nx; }
        const unsigned old = xb_add(&bar[XB_XSUB(b.x)], 1u);
        const unsigned gen = old / nloc;
        if (old + 1u == (gen + 1u) * nloc) {
            __builtin_amdgcn_fence(__ATOMIC_RELEASE, "agent");
            asm volatile("s_waitcnt vmcnt(0)" ::: "memory");
            const unsigned og = xb_add(&bar[XB_TOP], 1u);
            const unsigned tg = og / nx;
            if (og + 1u == (tg + 1u) * nx) xb_add(&bar[XB_TOPGEN], 1u);
            else XB_SPIN(xb_ld(&bar[XB_TOPGEN]) == tg, bar);
            __builtin_amdgcn_fence(__ATOMIC_ACQUIRE, "agent");
            xb_add(&bar[XB_XGEN(b.x)], 1u);
            asm volatile("s_waitcnt vmcnt(0)" ::: "memory");
        } else {
            XB_SPIN(xb_ld(&bar[XB_XGEN(b.x)]) == gen, bar);
            __builtin_amdgcn_fence(__ATOMIC_ACQUIRE, "agent");
            asm volatile("s_waitcnt vmcnt(0)" ::: "memory");
        }
    }
    __syncthreads();
}


struct Frame {
    LAS unsigned char* lds;
    volatile LAS unsigned* MISC;
    gu32* ctl;
    int tid, lane, wave;
    int vcu, G;
    unsigned char* ws;
    const float *x, *p, *norm_mix_g, *w_in, *conv_w, *shift_mu, *w_lora_up, *w0, *a_lora_up, *a0, *g_lora_up, *k_k, *k_a, *r_k, *ln_x_g, *ln_x_b, *w_out, *norm_mlp_g, *w_up, *w_down, *norm_ple_g, *w_ple_gate, *w_ple_proj, *norm_final_g;
    float* out;
};
DI float wave_sum(float v) {
#pragma unroll
    for (int o = 1; o < 64; o <<= 1) v += __shfl_xor(v, o);
    return v;
}
DI void p0_transpose_item(const float* W, int K, int N, bf16* WT, int row_off, const float* gk, LAS float* scr, int item, int lane) {
    const int nblk = N / 32, kb = item / nblk, nb = item % nblk, k0 = 64 * kb, n0 = 32 * nb;
#pragma unroll 8
    for (int i = 0; i < 32; ++i) { const int kk = 2 * i + (lane >> 5); float v = W[(size_t)(k0 + kk) * N + n0 + (lane & 31)]; if (gk) v *= gk[k0 + kk]; scr[kk * 33 + (lane & 31)] = v; }
    LDS_WAIT(); asm volatile("" ::: "memory");
    const int c = lane & 7;
#pragma unroll
    for (int j = 0; j < 4; ++j) { const int n = (lane >> 3) + 8 * j; const LAS float* s = scr + (8 * c) * 33 + n;
        v4u o; o.x = pk2(s[0 * 33], s[1 * 33]); o.y = pk2(s[2 * 33], s[3 * 33]); o.z = pk2(s[4 * 33], s[5 * 33]); o.w = pk2(s[6 * 33], s[7 * 33]);
        *(GAS v4u*)(WT + (size_t)(row_off + n0 + n) * K + k0 + 8 * c) = o; }
    LDS_WAIT(); asm volatile("" ::: "memory");
}
DI void rms_row_to_bf16(Frame& F, const float* xrow, const float* g, bf16* orow) {
    const GAS f32x4* xr = (const GAS f32x4*)xrow + F.lane; const GAS f32x4* gr = (const GAS f32x4*)g + F.lane;
    f32x4 v[4]; float s = 0.f;
#pragma unroll
    for (int j = 0; j < 4; ++j) { v[j] = xr[64 * j]; s += (v[j].x * v[j].x + v[j].y * v[j].y) + (v[j].z * v[j].z + v[j].w * v[j].w); }
    const float rstd = rsqrtf(wave_sum(s) * (1.f / D) + RMS_EPS);
    GAS unsigned long long* o8 = (GAS unsigned long long*)orow + F.lane;
#pragma unroll
    for (int j = 0; j < 4; ++j) { const f32x4 gg = gr[64 * j]; o8[64 * j] = (unsigned long long)pk2(v[j].x * rstd * gg.x, v[j].y * rstd * gg.y) | ((unsigned long long)pk2(v[j].z * rstd * gg.z, v[j].w * rstd * gg.w) << 32); }
}
DI void p0_prologue(Frame& F) {
    LAS float* scr = (LAS float*)(F.lds + F.wave * 16384);
    const int gw = F.vcu * NWAVES + F.wave, NGW = F.G * NWAVES;
    bf16* WIN = (bf16*)(F.ws + WS_WIN); bf16* WOUT = (bf16*)(F.ws + WS_WOUT); bf16* WUP = (bf16*)(F.ws + WS_WUP); bf16* WDN = (bf16*)(F.ws + WS_WDN); bf16* WG = (bf16*)(F.ws + WS_WG); bf16* WPLE = (bf16*)(F.ws + WS_WPLE);
    bf16* WL = (bf16*)(F.ws + WS_WL); bf16* AL = (bf16*)(F.ws + WS_AL); bf16* GL = (bf16*)(F.ws + WS_GL);
    constexpr int I_IN = (D / 64) * (IN_COLS / 32), I_OUT = (D / 64) * (D / 32), I_UP = (D / 64) * (FF / 32), I_DN = (FF / 64) * (D / 32), I_G = I_OUT, I_PLE = (PLE / 64) * (D / 32), I_WL = (RANK_W / 64) * (RWD / 32), I_AL = I_WL;
    constexpr int NITEMS = I_IN + I_OUT + I_UP + I_DN + I_G + I_PLE + I_WL + I_AL;
    for (int it = gw; it < NITEMS; it += NGW) {
        int r = it;
        if (r < I_IN) { p0_transpose_item(F.w_in, D, IN_COLS, WIN, 0, nullptr, scr, r, F.lane); continue; } r -= I_IN;
        if (r < I_OUT) { p0_transpose_item(F.w_out, D, D, WOUT, 0, nullptr, scr, r, F.lane); continue; } r -= I_OUT;
        if (r < I_UP) { p0_transpose_item(F.w_up, D, FF, WUP, 0, F.norm_mlp_g, scr, r, F.lane); continue; } r -= I_UP;
        if (r < I_DN) { p0_transpose_item(F.w_down, FF, D, WDN, 0, nullptr, scr, r, F.lane); continue; } r -= I_DN;
        if (r < I_G) { p0_transpose_item(F.w_ple_gate, D, D, WG, 0, F.norm_ple_g, scr, r, F.lane); continue; } r -= I_G;
        if (r < I_PLE) { p0_transpose_item(F.w_ple_proj, PLE, D, WPLE, 0, nullptr, scr, r, F.lane); continue; } r -= I_PLE;
        if (r < I_WL) { p0_transpose_item(F.w_lora_up, RANK_W, RWD, WL, 0, nullptr, scr, r, F.lane); continue; } r -= I_WL;
        p0_transpose_item(F.a_lora_up, RANK_A, RWD, AL, 0, nullptr, scr, r, F.lane);
    }
    const int gt = F.vcu * (NWAVES * 64) + F.tid, NGT = F.G * NWAVES * 64;
    for (int i = gt; i < (IN_PAD - IN_COLS) * D / 8; i += NGT) ((GAS v4u*)(WIN + (size_t)IN_COLS * D))[i] = (v4u){0u, 0u, 0u, 0u};
    for (int i = gt; i < RWD * RANK_G; i += NGT) { const int n = i / RANK_G, rho = i % RANK_G; GL[i] = (bf16)f2bf(F.g_lora_up[(size_t)rho * RWD + n]); }
    bf16* XN = (bf16*)(F.ws + WS_ABUF); bf16* PB = (bf16*)(F.ws + WS_PB);
    for (int m = gw; m < M; m += NGW) {
        rms_row_to_bf16(F, F.x + (size_t)m * D, F.norm_mix_g, XN + (size_t)m * D);
        const f32x4 pv = ((const GAS f32x4*)(F.p + (size_t)m * PLE))[F.lane];
        ((GAS unsigned long long*)(PB + (size_t)m * PLE))[F.lane] = (unsigned long long)pk2(pv.x, pv.y) | ((unsigned long long)pk2(pv.z, pv.w) << 32);
    }
}
DI void final_norm(Frame& F) {
    const int gw = F.vcu * NWAVES + F.wave, NGW = F.G * NWAVES;
    const float* ssq = (const float*)(F.ws + WS_SSQ3);
    const GAS f32x4* gr = (const GAS f32x4*)F.norm_final_g + F.lane;
    f32x4 gg[4];
#pragma unroll
    for (int j = 0; j < 4; ++j) gg[j] = gr[64 * j];
    for (int m = gw; m < M; m += NGW) {
        const f32x4 s4 = *(const GAS f32x4*)(ssq + (size_t)m * 4); const float rstd = rsqrtf(((s4[0] + s4[1]) + (s4[2] + s4[3])) * (1.f / D) + RMS_EPS);
        GAS f32x4* xr = (GAS f32x4*)(F.out + (size_t)m * D) + F.lane;
#pragma unroll
        for (int j = 0; j < 4; ++j) { f32x4 v = xr[64 * j]; v = v * rstd * gg[j]; xr[64 * j] = v; }
    }
}

#define MFMA16(a, b, c) __builtin_amdgcn_mfma_f32_16x16x32_bf16((a), (b), (c), 0, 0, 0)
DI void load_shift8(const bf16* proj, size_t row, bool has_prev, int col, const float* shift_mu, float (&o)[8]) {
    const v4u c = *(const GAS v4u*)(proj + row * PROJ_LD + col);
    v4u p = (v4u){0u, 0u, 0u, 0u}; if (has_prev) p = *(const GAS v4u*)(proj + (row - 1) * PROJ_LD + col);
    const f32x4 m0 = *(const GAS f32x4*)(shift_mu + (col - CONV_COLS)), m1 = *(const GAS f32x4*)(shift_mu + (col - CONV_COLS) + 4);
    float cu[8], pr[8]; unpack8(c, cu); unpack8(p, pr);
    const float mu[8] = {m0[0], m0[1], m0[2], m0[3], m1[0], m1[1], m1[2], m1[3]};
#pragma unroll
    for (int j = 0; j < 8; ++j) o[j] = cu[j] + mu[j] * (pr[j] - cu[j]);
}
DI void ld8f(const float* g, float (&o)[8]) { const f32x4 a = *(const GAS f32x4*)g, b = *(const GAS f32x4*)(g + 4); o[0] = a[0]; o[1] = a[1]; o[2] = a[2]; o[3] = a[3]; o[4] = b[0]; o[5] = b[1]; o[6] = b[2]; o[7] = b[3]; }
DI void lds_ld8f(const LAS float* g, float (&o)[8]) { const f32x4 a = *(const LAS f32x4*)g, b = *(const LAS f32x4*)(g + 4); o[0] = a[0]; o[1] = a[1]; o[2] = a[2]; o[3] = a[3]; o[4] = b[0]; o[5] = b[1]; o[6] = b[2]; o[7] = b[3]; }
DI void lds_st8f(LAS float* g, const float (&v)[8]) { *(LAS f32x4*)g = (f32x4){v[0], v[1], v[2], v[3]}; *(LAS f32x4*)(g + 4) = (f32x4){v[4], v[5], v[6], v[7]}; }
template <int KS> DI void mm_ll(f32x4& acc, const LAS bf16* A, int lda, const LAS bf16* Bt, int ldb, int mt, int nt, int fr, int fq) {
#pragma unroll
    for (int s = 0; s < KS; ++s) { const bf16x8 a = *(const LAS bf16x8*)(A + (mt * 16 + fr) * lda + s * 32 + fq * 8); const bf16x8 b = *(const LAS bf16x8*)(Bt + (nt * 16 + fr) * ldb + s * 32 + fq * 8);
        acc = MFMA16(b, a, acc); }
}
template <int KS> DI void mm_lg(f32x4& acc, const LAS bf16* A, int lda, const bf16* Bt, int ldb, int mt, int nt, int fr, int fq) {
#pragma unroll
    for (int s = 0; s < KS; ++s) { const bf16x8 a = *(const LAS bf16x8*)(A + (mt * 16 + fr) * lda + s * 32 + fq * 8); const bf16x8 b = *(const GAS bf16x8*)(Bt + (size_t)(nt * 16 + fr) * ldb + s * 32 + fq * 8);
        acc = MFMA16(b, a, acc); }
}

DI void rw_prep1(Frame& F, const bf16* proj, int b, int h, int c, LAS bf16* XW, LAS bf16* XA, float (&r8)[8], float (&k8)[8], float (&v8)[8]) {
    const int t = F.tid >> 3, cg = F.tid & 7, tau = c * CH + t; const size_t row = (size_t)b * T + tau; const bool hp = tau > 0;
    load_shift8(proj, row, hp, C_R + h * HD + cg * 8, F.shift_mu, r8);
    load_shift8(proj, row, hp, C_K + h * HD + cg * 8, F.shift_mu, k8);
    load_shift8(proj, row, hp, C_V + h * HD + cg * 8, F.shift_mu, v8);
    float xw[8], xa[8];
    load_shift8(proj, row, hp, C_XW + cg * 8, F.shift_mu, xw);
    load_shift8(proj, row, hp, C_XA + cg * 8, F.shift_mu, xa);
#pragma unroll
    for (int j = 0; j < 8; ++j) xw[j] = tanhf(xw[j]);
    *(LAS v4u*)(XW + t * MLD + cg * 8) = pack8(xw);
    *(LAS v4u*)(XA + t * MLD + cg * 8) = pack8(xa);
}
DI void rw_lora(Frame& F, int h, const LAS bf16* XW, const LAS bf16* XA, LAS float* LW, LAS float* IC) {
    const int mt = F.wave >> 1, nt0 = (F.wave & 1) * 2, fr = F.lane & 15, fq = F.lane >> 4;
    const bf16* WL = (const bf16*)(F.ws + WS_WL) + (size_t)h * HD * RANK_W; const bf16* AL = (const bf16*)(F.ws + WS_AL) + (size_t)h * HD * RANK_A;
#pragma unroll
    for (int q = 0; q < 2; ++q) { const int nt = nt0 + q; const int n0 = nt * 16 + 4 * fq;
        f32x4 aw = (f32x4){0.f, 0.f, 0.f, 0.f}, aa = aw;
        mm_lg<2>(aw, XW, MLD, WL, RANK_W, mt, nt, fr, fq);
        mm_lg<2>(aa, XA, MLD, AL, RANK_A, mt, nt, fr, fq);
        const f32x4 w0v = *(const GAS f32x4*)(F.w0 + h * HD + n0), a0v = *(const GAS f32x4*)(F.a0 + h * HD + n0);
        f32x4 lw, ic;
#pragma unroll
        for (int i = 0; i < 4; ++i) { const float z = aw[i] + w0v[i]; const float xs = -z; const float sp = fmaxf(xs, 0.f) + log1pf(expf(-fabsf(xs))); lw[i] = -expf(-sp - 0.5f); ic[i] = sigmoidf_(aa[i] + a0v[i]); }
        *(LAS f32x4*)(LW + (mt * 16 + fr) * 64 + n0) = lw; *(LAS f32x4*)(IC + (mt * 16 + fr) * 64 + n0) = ic; }
}
constexpr int GLD = 168;
DI void rw_gate_prep(Frame& F, const bf16* proj, int b, int c, LAS bf16* XG) {
    const int t = F.tid >> 3, cg = F.tid & 7, tau = c * CH + t; const size_t row = (size_t)b * T + tau; const bool hp = tau > 0;
#pragma unroll
    for (int q = 0; q < 3; ++q) { const int g8 = cg + 8 * q; if (g8 < RANK_G / 8) { float xg[8]; load_shift8(proj, row, hp, C_XG + g8 * 8, F.shift_mu, xg);
#pragma unroll
        for (int j = 0; j < 8; ++j) xg[j] = sigmoidf_(xg[j]);
        *(LAS v4u*)(XG + t * GLD + g8 * 8) = pack8(xg); } }
}
DI void rw_gate_mm(Frame& F, int h, const LAS bf16* XG, LAS float* Gm) {
    const int mt = F.wave >> 1, nt0 = (F.wave & 1) * 2, fr = F.lane & 15, fq = F.lane >> 4;
    const bf16* GL = (const bf16*)(F.ws + WS_GL) + (size_t)h * HD * RANK_G;
#pragma unroll
    for (int q = 0; q < 2; ++q) { const int nt = nt0 + q; f32x4 ag = (f32x4){0.f, 0.f, 0.f, 0.f};
        mm_lg<5>(ag, XG, GLD, GL, RANK_G, mt, nt, fr, fq);
        *(LAS f32x4*)(Gm + (mt * 16 + fr) * 64 + nt * 16 + 4 * fq) = ag; }
}
DI void rw_out_epi(Frame& F, int b, int h, int c, const float (&y8)[8], const float (&v8)[8], float cb, const float (&g8)[8]) {
    const int t = F.tid >> 3, cg = F.tid & 7; const size_t row = (size_t)b * T + c * CH + t;
    float s = 0.f;
#pragma unroll
    for (int j = 0; j < 8; ++j) s += y8[j];
    const float mean = red8(s) * (1.f / 64.f); float q = 0.f;
#pragma unroll
    for (int j = 0; j < 8; ++j) { const float d = y8[j] - mean; q += d * d; }
    const float rstd = rsqrtf(red8(q) * (1.f / 64.f) + GN_EPS);
    float lg[8], lb[8], o[8]; ld8f(F.ln_x_g + h * HD + cg * 8, lg); ld8f(F.ln_x_b + h * HD + cg * 8, lb);
#pragma unroll
    for (int j = 0; j < 8; ++j) o[j] = ((y8[j] - mean) * rstd * lg[j] + lb[j] + cb * v8[j]) * g8[j];
    bf16* mix = (bf16*)(F.ws + WS_MIX);
    *(GAS v4u*)(mix + row * D + CONVD + h * HD + cg * 8) = pack8(o);
}
DI void conv_phase(Frame& F, int wg_idx, int nwg) {
    const bf16* proj = (const bf16*)(F.ws + WS_PROJ); bf16* mix = (bf16*)(F.ws + WS_MIX);
    const int cg = F.tid & 63, rsub = F.tid >> 6, ch = cg * 8;
    float w0[8], w1[8], w2[8]; ld8f(F.conv_w + ch, w0); ld8f(F.conv_w + CONVD + ch, w1); ld8f(F.conv_w + 2 * CONVD + ch, w2);
    for (int m = wg_idx * 8 + rsub; m < M; m += nwg * 8) {
        const int tau = m % T; const bf16* pr = proj + (size_t)m * PROJ_LD;
        float gb[8], gc[8], hx[8], u0[8], u1[8], u2[8];
        unpack8(*(const GAS v4u*)(pr + ch), gb);
        unpack8(*(const GAS v4u*)(pr + CONVD + ch), gc); unpack8(*(const GAS v4u*)(pr + 2 * CONVD + ch), hx);
#pragma unroll
        for (int j = 0; j < 8; ++j) u2[j] = gc[j] * hx[j];
        if (tau >= 1) { unpack8(*(const GAS v4u*)(pr - PROJ_LD + CONVD + ch), gc); unpack8(*(const GAS v4u*)(pr - PROJ_LD + 2 * CONVD + ch), hx);
#pragma unroll
            for (int j = 0; j < 8; ++j) u1[j] = gc[j] * hx[j]; }
        else {
#pragma unroll
            for (int j = 0; j < 8; ++j) u1[j] = 0.f; }
        if (tau >= 2) { unpack8(*(const GAS v4u*)(pr - 2 * PROJ_LD + CONVD + ch), gc); unpack8(*(const GAS v4u*)(pr - 2 * PROJ_LD + 2 * CONVD + ch), hx);
#pragma unroll
            for (int j = 0; j < 8; ++j) u0[j] = gc[j] * hx[j]; }
        else {
#pragma unroll
            for (int j = 0; j < 8; ++j) u0[j] = 0.f; }
        float o[8];
#pragma unroll
        for (int j = 0; j < 8; ++j) o[j] = gb[j] * (u0[j] * w0[j] + u1[j] * w1[j] + u2[j] * w2[j]);
        *(GAS v4u*)(mix + (size_t)m * D + ch) = pack8(o);
    }
}
DI void rwkv_naive_chain(Frame& F, int chain) {
    const int b = chain / NH, h = chain % NH;
    const bf16* proj = (const bf16*)(F.ws + WS_PROJ);
    LAS float* F0 = (LAS float*)(F.lds);
    LAS float* F1 = F0 + 4096;
    LAS float* FR = F0 + 2 * 4096; LAS float* FK = F0 + 3 * 4096; LAS float* FV = F0 + 4 * 4096; LAS float* FA = F0 + 5 * 4096; LAS float* FB = F0 + 6 * 4096;
    LAS bf16* XW = (LAS bf16*)(F.lds + 7 * 16384); LAS bf16* XA = XW + 64 * MLD;
    LAS bf16* XG = (LAS bf16*)FA;
    LAS float* Gm = FR;
    const int t = F.tid >> 3, cg = F.tid & 7;
    float S[8];
#pragma unroll
    for (int j = 0; j < 8; ++j) S[j] = 0.f;
    float kkw[8], kaw[8], rkw[8]; ld8f(F.k_k + h * HD + cg * 8, kkw); ld8f(F.k_a + h * HD + cg * 8, kaw); ld8f(F.r_k + h * HD + cg * 8, rkw);
    for (int c = 0; c < NCH; ++c) {
        float r8[8], k8[8], v8[8];
        rw_prep1(F, proj, b, h, c, XW, XA, r8, k8, v8);
        LDS_WAIT(); __syncthreads();
        rw_lora(F, h, XW, XA, F0, F1);
        LDS_WAIT(); __syncthreads();
        float lw[8], ic[8]; lds_ld8f(F0 + t * 64 + cg * 8, lw); lds_ld8f(F1 + t * 64 + cg * 8, ic);
        float kk[8], ss = 0.f;
#pragma unroll
        for (int j = 0; j < 8; ++j) { kk[j] = k8[j] * kkw[j]; ss += kk[j] * kk[j]; }
        const float inv = 1.0f / fmaxf(sqrtf(red8(ss)), L2_EPS);
        float kh[8], a8[8], b8[8], w8[8], cbp = 0.f;
#pragma unroll
        for (int j = 0; j < 8; ++j) { const float kn = kk[j] * inv; kh[j] = k8[j] * (1.0f + (ic[j] - 1.0f) * kaw[j]); a8[j] = -kn; b8[j] = kn * ic[j]; w8[j] = expf(lw[j]); cbp += r8[j] * kh[j] * rkw[j]; }
        const float cb = red8(cbp);
        __syncthreads();
        lds_st8f(F0 + t * 64 + cg * 8, w8); lds_st8f(FR + t * 64 + cg * 8, r8); lds_st8f(FK + t * 64 + cg * 8, kh); lds_st8f(FV + t * 64 + cg * 8, v8); lds_st8f(FA + t * 64 + cg * 8, a8); lds_st8f(FB + t * 64 + cg * 8, b8);
        LDS_WAIT(); __syncthreads();
        for (int s = 0; s < CH; ++s) {
            float aa[8], bb[8], ww[8], kx[8], rr[8];
            lds_ld8f(FA + s * 64 + cg * 8, aa); lds_ld8f(FB + s * 64 + cg * 8, bb); lds_ld8f(F0 + s * 64 + cg * 8, ww); lds_ld8f(FK + s * 64 + cg * 8, kx); lds_ld8f(FR + s * 64 + cg * 8, rr);
            const float vi = FV[s * 64 + t];
            float sa = 0.f;
#pragma unroll
            for (int j = 0; j < 8; ++j) sa += S[j] * aa[j];
            sa = red8(sa);
            float y = 0.f;
#pragma unroll
            for (int j = 0; j < 8; ++j) { S[j] = S[j] * ww[j] + sa * bb[j] + vi * kx[j]; y += S[j] * rr[j]; }
            y = red8(y);
            if (cg == 0) F1[s * 64 + t] = y;
        }
        LDS_WAIT(); __syncthreads();
        rw_gate_prep(F, proj, b, c, XG);
        LDS_WAIT(); __syncthreads();
        rw_gate_mm(F, h, XG, Gm);
        LDS_WAIT(); __syncthreads();
        float y8[8], g8[8]; lds_ld8f(F1 + t * 64 + cg * 8, y8); lds_ld8f(Gm + t * 64 + cg * 8, g8);
        rw_out_epi(F, b, h, c, y8, v8, cb, g8);
        __syncthreads();
    }
}

constexpr int NPH = 8;
struct Args { const float* in[24]; float* out; unsigned char* ws; int ph_lo, ph_hi, li, pad; };
__global__ void __launch_bounds__(NWAVES * 64, 2) mk_fwd(Args args) {
    extern __shared__ __attribute__((aligned(16))) unsigned char lds[];
    Frame F;
    F.lds = (LAS unsigned char*)lds;
    F.MISC = (volatile LAS unsigned*)(F.lds + LDSCTL_OFF);
    F.tid = threadIdx.x; F.lane = F.tid & 63; F.wave = __builtin_amdgcn_readfirstlane(F.tid >> 6);
    F.G = gridDim.x; { const int bx = blockIdx.x; F.vcu = (F.G % 8 == 0) ? (bx % 8) * (F.G / 8) + bx / 8 : bx; }
    F.ws = args.ws; F.ctl = (gu32*)(args.ws + WS_CTL); F.out = args.out;
    F.x = args.in[0]; F.p = args.in[1]; F.norm_mix_g = args.in[2]; F.w_in = args.in[3]; F.conv_w = args.in[4]; F.shift_mu = args.in[5]; F.w_lora_up = args.in[6]; F.w0 = args.in[7];
    F.a_lora_up = args.in[8]; F.a0 = args.in[9]; F.g_lora_up = args.in[10]; F.k_k = args.in[11]; F.k_a = args.in[12]; F.r_k = args.in[13]; F.ln_x_g = args.in[14]; F.ln_x_b = args.in[15];
    F.w_out = args.in[16]; F.norm_mlp_g = args.in[17]; F.w_up = args.in[18]; F.w_down = args.in[19]; F.norm_ple_g = args.in[20]; F.w_ple_gate = args.in[21]; F.w_ple_proj = args.in[22]; F.norm_final_g = args.in[23];
    for (int u = F.tid; u < (LDS_BYTES - LDSCTL_OFF) / 4; u += NWAVES * 64) ((LAS unsigned*)(F.lds + LDSCTL_OFF))[u] = 0u;
    __syncthreads();
    XcdBarrier bar; bar.bar = (unsigned*)(F.ctl + CW_BAR) + args.li * XCD_BAR_WORDS; bar.x = 0; bar.st = nullptr;
    if (N_LAUNCHES == 1) bar = xcd_barrier_post((unsigned*)(F.ctl + CW_BAR), F.MISC + 8);
    const int lo = args.ph_lo, hi = args.ph_hi;
#define IN(k) (lo <= (k) && (k) < hi)
#define SEAM(k) do { if (IN(k) && IN((k) + 1)) xcd_barrier(bar); } while (0)
    bf16* ABUF = (bf16*)(F.ws + WS_ABUF); bf16* PROJ = (bf16*)(F.ws + WS_PROJ); bf16* MIX = (bf16*)(F.ws + WS_MIX); bf16* PLEB = (bf16*)(F.ws + WS_PLE); bf16* HSQ = (bf16*)(F.ws + WS_HSQ); bf16* PB = (bf16*)(F.ws + WS_PB);
    float* SSQ1 = (float*)(F.ws + WS_SSQ1); float* SSQ2 = (float*)(F.ws + WS_SSQ2); float* SSQ3 = (float*)(F.ws + WS_SSQ3);

    if (IN(0)) { p0_prologue(F); } SEAM(0);
    if (IN(1)) {
        { pg8::Gemm g{ABUF, (const bf16*)(F.ws + WS_WIN), M, IN_PAD, D}; pg8::StaticOrder S; S.init(M, IN_PAD, F.G, (int)blockIdx.x);
          pg8::EpiBf16G E{PROJ, PROJ_LD, IN_COLS};
          pg8::gemm_phase<pg8::EpiBf16G, pg8::StaticOrder, PG8_ALIGN, PG8_SP2>(F.lds, g, S, E); }
        { pg8::Gemm g{PB, (const bf16*)(F.ws + WS_WPLE), M, D, PLE}; pg8::StaticOrder S; S.init(M, D, F.G, (int)blockIdx.x);
          pg8::EpiBf16G E{PLEB, D, D};
          pg8::gemm_phase<pg8::EpiBf16G, pg8::StaticOrder, PG8_ALIGN, PG8_SP2>(F.lds, g, S, E); }
    } SEAM(1);
    if (IN(2)) {
        if (F.vcu < BATCH * NH) rwkv_naive_chain(F, F.vcu);
        else conv_phase(F, F.vcu - BATCH * NH, F.G - BATCH * NH);
    } SEAM(2);
    if (IN(3)) {
        pg8::Gemm g{MIX, (const bf16*)(F.ws + WS_WOUT), M, D, D}; pg8::StaticOrder S; S.init(M, D, F.G, (int)blockIdx.x);
        pg8::EpiRes E{F.x, F.out, ABUF, SSQ1, D};
        pg8::gemm_phase<pg8::EpiRes, pg8::StaticOrder, false, PG8_SP2>(F.lds, g, S, E);
    } SEAM(3);
    if (IN(4)) {
        pg8::Gemm g{ABUF, (const bf16*)(F.ws + WS_WUP), M, FF, D}; pg8::StaticOrder S; S.init(M, FF, F.G, (int)blockIdx.x);
        pg8::EpiSqRelu E{HSQ, FF, SSQ1, 1.f / D, RMS_EPS};
        pg8::gemm_phase<pg8::EpiSqRelu, pg8::StaticOrder, PG8_ALIGN, PG8_SP2>(F.lds, g, S, E);
    } SEAM(4);
    if (IN(5)) {
        pg8::Gemm g{HSQ, (const bf16*)(F.ws + WS_WDN), M, D, FF}; pg8::StaticOrder S; S.init(M, D, F.G, (int)blockIdx.x);
        pg8::EpiRes E{F.out, F.out, ABUF, SSQ2, D};
        pg8::gemm_phase<pg8::EpiRes, pg8::StaticOrder, false, PG8_SP2>(F.lds, g, S, E);
    } SEAM(5);
    if (IN(6)) {
        pg8::Gemm g{ABUF, (const bf16*)(F.ws + WS_WG), M, D, D}; pg8::StaticOrder S; S.init(M, D, F.G, (int)blockIdx.x);
        pg8::EpiGate E{F.out, PLEB, SSQ2, SSQ3, D, 1.f / D, RMS_EPS};
        pg8::gemm_phase<pg8::EpiGate, pg8::StaticOrder, false, PG8_SP2>(F.lds, g, S, E);
    } SEAM(6);
    if (IN(7)) { final_norm(F); }
#undef IN
#undef SEAM
}

extern "C" void kernel_launch(void* const* d_in, const int* in_sizes, int n_in, void* d_out, int out_size, void* d_ws, size_t ws_size, hipStream_t stream) {
    static int grid = 0;
    if (grid == 0) {
        if (n_in != 24 || in_sizes[0] != M * D || out_size != M * D || ws_size < WS_END) { fprintf(stderr, "kernel_launch: unexpected shapes: n_in %d in0 %d out %d ws %zu\n", n_in, n_in > 0 ? in_sizes[0] : -1, out_size, ws_size); grid = -1; return; }
        int dev = 0, cus = 0, per_cu = 0;
        if (hipGetDevice(&dev) != hipSuccess || hipDeviceGetAttribute(&cus, hipDeviceAttributeMultiprocessorCount, dev) != hipSuccess) { fprintf(stderr, "kernel_launch: device query failed\n"); grid = -1; return; }
        if (hipFuncSetAttribute((const void*)mk_fwd, hipFuncAttributeMaxDynamicSharedMemorySize, LDS_BYTES) != hipSuccess) { fprintf(stderr, "kernel_launch: hipFuncSetAttribute failed\n"); grid = -1; return; }
        if (hipOccupancyMaxActiveBlocksPerMultiprocessor(&per_cu, (const void*)mk_fwd, NWAVES * 64, LDS_BYTES) != hipSuccess || per_cu < 1)
            fprintf(stderr, "kernel_launch: note: occupancy query reports %d workgroups per CU\n", per_cu);
        (void)hipGetLastError();
        grid = cus;
        if (grid != 256) { fprintf(stderr, "kernel_launch: this kernel needs a 256-CU device (got %d)\n", grid); grid = -1; return; }
    }
    if (grid < 0) return;
    if (hipMemsetAsync((char*)d_ws + WS_CTL, 0, CTL_ZERO_BYTES, stream) != hipSuccess) { fprintf(stderr, "kernel_launch: hipMemsetAsync failed\n"); return; }
    Args a{};
    for (int i = 0; i < 24; ++i) a.in[i] = (const float*)d_in[i];
    a.out = (float*)d_out; a.ws = (unsigned char*)d_ws;
    if (N_LAUNCHES == 1) { a.ph_lo = 0; a.ph_hi = NPH; a.li = 0; hipLaunchKernelGGL(mk_fwd, dim3(grid), dim3(NWAVES * 64), LDS_BYTES, stream, a); }
    else for (int li = 0; li < NPH; ++li) { a.ph_lo = li; a.ph_hi = li + 1; a.li = 0; hipLaunchKernelGGL(mk_fwd, dim3(grid), dim3(NWAVES * 64), LDS_BYTES, stream, a); }
    const hipError_t le = hipPeekAtLastError();
    if (le != hipSuccess) fprintf(stderr, "kernel_launch: launch failed: %s\n", hipGetErrorName(le));
}
```

```cpp
#include <hip/hip_runtime.h>
#include <cstdio>
#include <cstdint>

namespace pg8 {
#define PG8_LAS __attribute__((address_space(3)))
typedef unsigned short bf16_t;
typedef short bf16x8 __attribute__((ext_vector_type(8)));
typedef float f32x4 __attribute__((ext_vector_type(4)));
typedef unsigned u32x4 __attribute__((ext_vector_type(4)));
constexpr int BM = 256, BK = 64, HALF = 128, HTB = HALF * BK * 2  , STAGE_BYTES = 8 * HTB, NXCD = 8, WGM = 8;

__host__ __device__ __forceinline__ int lds_byte(int r, int c) { const int st = (r >> 4) * 2 + (c >> 5), rr = r & 15, cc = c & 31, ob = rr * 64 + cc * 2; return st * 1024 + (ob ^ (((ob >> 9) & 1) << 5)); }
__host__ __device__ __forceinline__ void stage_rc(int b, int& R, int& C) { const int st = b / 1024, sb = b % 1024, swz = sb ^ (((sb >> 9) & 1) << 5); R = (st >> 1) * 16 + swz / 64; C = (st & 1) * 32 + (swz % 64) / 2; }
__host__ __device__ __forceinline__ int perm32(int rho) { const int n = rho >> 4, i = rho & 15; return 8 * (i >> 2) + 4 * n + (i & 3); }

struct Unit { int pm, pn; };
struct Gemm { const bf16_t* A; const bf16_t* Bt; int M, N, K; };

struct StaticOrder {
    int nM, nN, nwg, G, c;
    __host__ __device__ void init(int M, int N, int G_, int c_) { nM = M / BM; nN = N / BM; nwg = nM * nN; G = G_; c = c_; }
    __host__ __device__ bool next(int i, Unit& u) const {
        const long L = (long)i * G + c; if (L >= nwg) return false;
        int wgid = (int)L; { const int q = nwg / NXCD, r = nwg % NXCD, xcd = wgid % NXCD, off = wgid / NXCD; wgid = (xcd < r ? xcd * (q + 1) : r * (q + 1) + (xcd - r) * q) + off; }
        const int nig = WGM * nN, gid = wgid / nig, fm = gid * WGM, gsz = (nM - fm) < WGM ? (nM - fm) : WGM;
        u.pm = fm + ((wgid % nig) % gsz); u.pn = (wgid % nig) / gsz; return true;
    }
    __device__ __forceinline__ void a_ready(const Unit&) const {}
    __device__ __forceinline__ void done(const Unit&) const {}
};

__device__ __forceinline__ unsigned cvt_pk_bf16(float lo, float hi) { unsigned r; asm volatile("v_cvt_pk_bf16_f32 %0, %1, %2" : "=v"(r) : "v"(lo), "v"(hi)); return r; }
typedef float f32x2 __attribute__((ext_vector_type(2)));

typedef unsigned u32x2 __attribute__((ext_vector_type(2)));
struct EpiBf16G {
    static constexpr bool PERM = true, AFTER_DRAIN = false;
    bf16_t* O; int ldc; int ncols;
    __device__ __forceinline__ void operator()(const f32x4 (&acc)[2][2][4][2], const Unit& u, int wr, int wc, int fr, int fq) const {
        const int row0 = u.pm * BM + wr * 64 + fr, col0 = u.pn * BM + wc * 32 + 8 * fq;
#pragma unroll
        for (int ai = 0; ai < 2; ++ai)
#pragma unroll
            for (int m = 0; m < 4; ++m) { bf16_t* rowp = O + (size_t)(row0 + ai * HALF + m * 16) * ldc + col0;
#pragma unroll
                for (int bj = 0; bj < 2; ++bj) { if (col0 + bj * HALF < ncols) { const f32x4 v0 = acc[ai][bj][m][0], v1 = acc[ai][bj][m][1];
                    u32x4 w; w.x = cvt_pk_bf16(v0[0], v0[1]); w.y = cvt_pk_bf16(v0[2], v0[3]); w.z = cvt_pk_bf16(v1[0], v1[1]); w.w = cvt_pk_bf16(v1[2], v1[3]);
                    *(u32x4*)(rowp + bj * HALF) = w; } } }
    }
};
struct EpiSqRelu {
    static constexpr bool PERM = true, AFTER_DRAIN = false;
    bf16_t* O; int ldc; const float* ssq; float inv_n, eps;
    __device__ __forceinline__ void operator()(const f32x4 (&acc)[2][2][4][2], const Unit& u, int wr, int wc, int fr, int fq) const {
        const int row0 = u.pm * BM + wr * 64 + fr, col0 = u.pn * BM + wc * 32 + 8 * fq;
#pragma unroll
        for (int ai = 0; ai < 2; ++ai)
#pragma unroll
            for (int m = 0; m < 4; ++m) { const int row = row0 + ai * HALF + m * 16; bf16_t* rowp = O + (size_t)row * ldc + col0;
                const f32x4 s4 = *(const f32x4*)(ssq + (size_t)row * 4); const float rs = rsqrtf(((s4[0] + s4[1]) + (s4[2] + s4[3])) * inv_n + eps);
#pragma unroll
                for (int bj = 0; bj < 2; ++bj) { f32x4 v0 = acc[ai][bj][m][0] * rs, v1 = acc[ai][bj][m][1] * rs;
#pragma unroll
                    for (int e = 0; e < 4; ++e) { const float a = fmaxf(v0[e], 0.f), b = fmaxf(v1[e], 0.f); v0[e] = a * a; v1[e] = b * b; }
                    u32x4 w; w.x = cvt_pk_bf16(v0[0], v0[1]); w.y = cvt_pk_bf16(v0[2], v0[3]); w.z = cvt_pk_bf16(v1[0], v1[1]); w.w = cvt_pk_bf16(v1[2], v1[3]);
                    *(u32x4*)(rowp + bj * HALF) = w; } }
    }
};
struct EpiRes {
    static constexpr bool PERM = false, AFTER_DRAIN = true;
    const float* base; float* out; bf16_t* hb; float* ssq; int ldc;
    __device__ __forceinline__ void fused(f32x4 (&acc)[2][2][4][2], const Unit& u, int wr, int wc, int fr, int fq, PG8_LAS unsigned char* lds, int wid, int lane) const {
        PG8_LAS float* P = (PG8_LAS float*)lds;
        const int col0 = u.pn * BM + wc * 32 + 4 * fq;
#pragma unroll
        for (int ai = 0; ai < 2; ++ai)
#pragma unroll
            for (int m = 0; m < 4; ++m) { const int r = ai * HALF + wr * 64 + m * 16 + fr; const size_t off = (size_t)(u.pm * BM + r) * ldc + col0; float ss = 0.f;
#pragma unroll
                for (int bj = 0; bj < 2; ++bj)
#pragma unroll
                    for (int n = 0; n < 2; ++n) { const size_t o2 = off + bj * HALF + n * 16; const f32x4 bs = *(const f32x4*)(base + o2); const f32x4 h = bs + acc[ai][bj][m][n];
                        *(f32x4*)(out + o2) = h; ss += (h[0] * h[0] + h[1] * h[1]) + (h[2] * h[2] + h[3] * h[3]);
                        u32x2 w; w.x = cvt_pk_bf16(h[0], h[1]); w.y = cvt_pk_bf16(h[2], h[3]); *(u32x2*)(hb + o2) = w; }
                ss += __shfl_xor(ss, 16); ss += __shfl_xor(ss, 32);
                if (fq == 0) P[r * 4 + wc] = ss;
                asm volatile("" ::: "memory"); }
        asm volatile("s_waitcnt lgkmcnt(0)" ::: "memory"); __builtin_amdgcn_s_barrier(); asm volatile("" ::: "memory");
        const int tid = wid * 64 + lane;
        if (tid < 256) { const f32x4 p = *(const PG8_LAS f32x4*)(P + tid * 4); ssq[(size_t)(u.pm * BM + tid) * 4 + u.pn] = (p[0] + p[1]) + (p[2] + p[3]); }
        asm volatile("s_waitcnt lgkmcnt(0)" ::: "memory"); __builtin_amdgcn_s_barrier(); asm volatile("" ::: "memory");
    }
};
struct EpiGate {
    static constexpr bool PERM = false, AFTER_DRAIN = true;
    float* io; const bf16_t* ple; const float* ssq_in; float* ssq_out; int ldc; float inv_n, eps;
    __device__ __forceinline__ void fused(f32x4 (&acc)[2][2][4][2], const Unit& u, int wr, int wc, int fr, int fq, PG8_LAS unsigned char* lds, int wid, int lane) const {
        PG8_LAS float* P = (PG8_LAS float*)lds;
        const int col0 = u.pn * BM + wc * 32 + 4 * fq;
#pragma unroll
        for (int ai = 0; ai < 2; ++ai)
#pragma unroll
            for (int m = 0; m < 4; ++m) { const int r = ai * HALF + wr * 64 + m * 16 + fr; const size_t off = (size_t)(u.pm * BM + r) * ldc + col0; float ss = 0.f;
                const f32x4 s4 = *(const f32x4*)(ssq_in + (size_t)(u.pm * BM + r) * 4); const float rs = rsqrtf(((s4[0] + s4[1]) + (s4[2] + s4[3])) * inv_n + eps);
#pragma unroll
                for (int bj = 0; bj < 2; ++bj)
#pragma unroll
                    for (int n = 0; n < 2; ++n) { const size_t o2 = off + bj * HALF + n * 16; const f32x4 h2 = *(const f32x4*)(io + o2); const u32x2 pw = *(const u32x2*)(ple + o2);
                        f32x4 pl; pl[0] = __uint_as_float(pw.x << 16); pl[1] = __uint_as_float(pw.x & 0xffff0000u); pl[2] = __uint_as_float(pw.y << 16); pl[3] = __uint_as_float(pw.y & 0xffff0000u);
                        f32x4 h; const f32x4 a = acc[ai][bj][m][n] * rs;
#pragma unroll
                        for (int e = 0; e < 4; ++e) { const float g = 1.0f / (1.0f + __expf(-a[e])); h[e] = h2[e] + g * pl[e]; }
                        *(f32x4*)(io + o2) = h; ss += (h[0] * h[0] + h[1] * h[1]) + (h[2] * h[2] + h[3] * h[3]); }
                ss += __shfl_xor(ss, 16); ss += __shfl_xor(ss, 32);
                if (fq == 0) P[r * 4 + wc] = ss;
                asm volatile("" ::: "memory"); }
        asm volatile("s_waitcnt lgkmcnt(0)" ::: "memory"); __builtin_amdgcn_s_barrier(); asm volatile("" ::: "memory");
        const int tid = wid * 64 + lane;
        if (tid < 256) { const f32x4 p = *(const PG8_LAS f32x4*)(P + tid * 4); ssq_out[(size_t)(u.pm * BM + tid) * 4 + u.pn] = (p[0] + p[1]) + (p[2] + p[3]); }
        asm volatile("s_waitcnt lgkmcnt(0)" ::: "memory"); __builtin_amdgcn_s_barrier(); asm volatile("" ::: "memory");
    }
};


template <class Epi, class Sched, bool ALIGN_EPI = false, bool SP2 = false>
__device__ __forceinline__ void gemm_phase(PG8_LAS unsigned char* lds, const Gemm g, const Sched& S, const Epi& E) {
    const int tid = threadIdx.x, wid = __builtin_amdgcn_readfirstlane(tid >> 6), lane = tid & 63, wr = wid >> 2, wc = wid & 3, fr = lane & 15, fq = lane >> 4;
    const int K = g.K, nt = K / BK;
    unsigned voffA[2], voffB[2];
#pragma unroll
    for (int i = 0; i < 2; ++i) { int R, C; stage_rc(tid * 16 + i * 8192, R, C); const int Rb = Epi::PERM ? ((R & ~31) + perm32(R & 31)) : R;
        voffA[i] = (unsigned)(R * K + C) * 2u; voffB[i] = (unsigned)(Rb * K + C) * 2u; }
    const size_t kstep = (size_t)(BK * 2);
    const size_t hstep = (size_t)HALF * K * 2;
    const size_t tstep = 2 * hstep;
    const unsigned ldsw = (unsigned)wid * 1024u;
    const int aoff = lds_byte(wr * 64 + fr, fq * 8), boff = lds_byte(wc * 32 + fr, fq * 8);
#define PG8_SA(b, h) (((b) * 2 + (h)) * HTB)
#define PG8_SB(b, h) ((4 + (b) * 2 + (h)) * HTB)
#define PG8_STAGE(bufoff, gbase, voff) do { _Pragma("unroll") for (int _i = 0; _i < 2; ++_i) \
        __builtin_amdgcn_global_load_lds((const unsigned*)((const char*)(gbase) + (voff)[_i]), (PG8_LAS unsigned*)(lds + (bufoff) + ldsw + _i * 8192), 16, 0, 0); } while (0)
#define PG8_LDA(dst, b, h) do { _Pragma("unroll") for (int m = 0; m < 4; ++m) _Pragma("unroll") for (int k = 0; k < 2; ++k) dst[m][k] = *(const PG8_LAS bf16x8*)(lds + PG8_SA(b, h) + aoff + m * 2048 + k * 1024); } while (0)
#define PG8_LDB(dst, b, h) do { _Pragma("unroll") for (int n = 0; n < 2; ++n) _Pragma("unroll") for (int k = 0; k < 2; ++k) dst[n][k] = *(const PG8_LAS bf16x8*)(lds + PG8_SB(b, h) + boff + n * 2048 + k * 1024); } while (0)
#define PG8_MMA(ai, bj, At, Bt) do { __builtin_amdgcn_s_setprio(1); _Pragma("unroll") for (int m = 0; m < 4; ++m) _Pragma("unroll") for (int n = 0; n < 2; ++n) _Pragma("unroll") for (int k = 0; k < 2; ++k) \
        acc[ai][bj][m][n] = __builtin_amdgcn_mfma_f32_16x16x32_bf16(Bt[n][k], At[m][k], acc[ai][bj][m][n], 0, 0, 0); __builtin_amdgcn_s_setprio(0); } while (0)
#define PG8_WAIT_V(n) asm volatile("s_waitcnt vmcnt(" #n ")" ::: "memory")
#define PG8_WAIT_L(n) asm volatile("s_waitcnt lgkmcnt(" #n ")" ::: "memory")
#define PG8_BAR __builtin_amdgcn_s_barrier()
#define PG8_SCHED __builtin_amdgcn_sched_barrier(0)
    Unit cur, nxt; int ui = 0;
    if (!S.next(0, cur)) return;
    f32x4 acc[2][2][4][2];
#pragma unroll
    for (int a = 0; a < 2; ++a)
#pragma unroll
        for (int b = 0; b < 2; ++b)
#pragma unroll
            for (int m = 0; m < 4; ++m)
#pragma unroll
                for (int n = 0; n < 2; ++n) acc[a][b][m][n] = (f32x4){0.f, 0.f, 0.f, 0.f};
    bf16x8 At[4][2], B0[2][2], B1[2][2];
    const char* cA = (const char*)g.A + (size_t)cur.pm * tstep; const char* cB = (const char*)g.Bt + (size_t)cur.pn * tstep;
    S.a_ready(cur);
    if constexpr (SP2) {
        PG8_STAGE(PG8_SB(0, 0), cB, voffB); PG8_STAGE(PG8_SB(0, 1), cB + hstep, voffB); PG8_STAGE(PG8_SA(0, 0), cA, voffA); PG8_STAGE(PG8_SA(0, 1), cA + hstep, voffA);
        if (wr == 1) PG8_BAR;
        PG8_WAIT_V(2); PG8_BAR;
        PG8_STAGE(PG8_SB(1, 0), cB + kstep, voffB); PG8_STAGE(PG8_SA(1, 0), cA + kstep, voffA); PG8_STAGE(PG8_SB(1, 1), cB + hstep + kstep, voffB);
        PG8_WAIT_V(6); PG8_BAR;
    } else {
        PG8_STAGE(PG8_SB(0, 0), cB, voffB); PG8_STAGE(PG8_SA(0, 0), cA, voffA); PG8_STAGE(PG8_SB(0, 1), cB + hstep, voffB); PG8_STAGE(PG8_SA(0, 1), cA + hstep, voffA);
        if (wr == 1) PG8_BAR;
        PG8_WAIT_V(4); PG8_BAR;
        PG8_STAGE(PG8_SB(1, 0), cB + kstep, voffB); PG8_STAGE(PG8_SA(1, 0), cA + kstep, voffA); PG8_STAGE(PG8_SB(1, 1), cB + hstep + kstep, voffB);
        PG8_WAIT_V(6); PG8_BAR;
    }
    for (;;) {
        const bool has_next = S.next(ui + 1, nxt);
        const char* nA = has_next ? (const char*)g.A + (size_t)nxt.pm * tstep : cA; const char* nB = has_next ? (const char*)g.Bt + (size_t)nxt.pn * tstep : cB;
        for (int t = 0; t < nt; t += 2) {
            const bool last = (t == nt - 2);
            const char* a1 = cA + (size_t)(t + 1) * kstep;
            const char* a2 = last ? nA : cA + (size_t)(t + 2) * kstep; const char* b2 = last ? nB : cB + (size_t)(t + 2) * kstep;
            const char* a3 = a2 + kstep; const char* b3 = b2 + kstep;
            if (last && has_next) S.a_ready(nxt);
            if constexpr (SP2) {
            PG8_LDB(B0, 0, 0); PG8_LDB(B1, 0, 1); PG8_SCHED; PG8_LDA(At, 0, 0); PG8_STAGE(PG8_SA(1, 1), a1 + hstep, voffA);
            PG8_WAIT_V(8); PG8_WAIT_L(0); PG8_BAR; PG8_MMA(0, 0, At, B0); PG8_MMA(0, 1, At, B1); PG8_BAR; PG8_SCHED;
            PG8_LDA(At, 0, 1); PG8_STAGE(PG8_SB(0, 0), b2, voffB); PG8_STAGE(PG8_SB(0, 1), b2 + hstep, voffB); PG8_STAGE(PG8_SA(0, 0), a2, voffA);
            PG8_WAIT_V(8); PG8_WAIT_L(0); PG8_BAR; PG8_MMA(1, 0, At, B0); PG8_MMA(1, 1, At, B1); PG8_BAR; PG8_SCHED;
            PG8_LDB(B0, 1, 0); PG8_LDB(B1, 1, 1); PG8_SCHED; PG8_LDA(At, 1, 0); PG8_STAGE(PG8_SA(0, 1), a2 + hstep, voffA);
            PG8_WAIT_V(8); PG8_WAIT_L(0); PG8_BAR; PG8_MMA(0, 0, At, B0); PG8_MMA(0, 1, At, B1); PG8_BAR; PG8_SCHED;
            PG8_LDA(At, 1, 1); PG8_STAGE(PG8_SB(1, 0), b3, voffB); PG8_STAGE(PG8_SB(1, 1), b3 + hstep, voffB); PG8_STAGE(PG8_SA(1, 0), a3, voffA);
            PG8_WAIT_V(8); PG8_WAIT_L(0); PG8_BAR; PG8_MMA(1, 0, At, B0); PG8_MMA(1, 1, At, B1); PG8_BAR; PG8_SCHED;
            } else {
            PG8_LDB(B0, 0, 0); PG8_SCHED; PG8_LDA(At, 0, 0); PG8_STAGE(PG8_SA(1, 1), a1 + hstep, voffA);
            PG8_WAIT_L(8); PG8_BAR; PG8_WAIT_L(0); PG8_MMA(0, 0, At, B0); PG8_BAR; PG8_SCHED;
            PG8_LDB(B1, 0, 1); PG8_STAGE(PG8_SB(0, 0), b2, voffB);
            PG8_BAR; PG8_WAIT_L(0); PG8_MMA(0, 1, At, B1); PG8_BAR;
            PG8_LDA(At, 0, 1); PG8_STAGE(PG8_SA(0, 0), a2, voffA);
            PG8_BAR; PG8_WAIT_L(0); PG8_MMA(1, 0, At, B0); PG8_BAR; PG8_SCHED;
            PG8_STAGE(PG8_SB(0, 1), b2 + hstep, voffB);
            PG8_WAIT_V(6); PG8_BAR; PG8_MMA(1, 1, At, B1); PG8_BAR;
            PG8_LDB(B0, 1, 0); PG8_SCHED; PG8_LDA(At, 1, 0); PG8_STAGE(PG8_SA(0, 1), a2 + hstep, voffA);
            PG8_WAIT_L(8); PG8_BAR; PG8_WAIT_L(0); PG8_MMA(0, 0, At, B0); PG8_BAR; PG8_SCHED;
            PG8_LDB(B1, 1, 1); PG8_STAGE(PG8_SB(1, 0), b3, voffB);
            PG8_BAR; PG8_WAIT_L(0); PG8_MMA(0, 1, At, B1); PG8_BAR;
            PG8_LDA(At, 1, 1); PG8_STAGE(PG8_SA(1, 0), a3, voffA);
            PG8_BAR; PG8_WAIT_L(0); PG8_MMA(1, 0, At, B0); PG8_BAR; PG8_SCHED;
            PG8_STAGE(PG8_SB(1, 1), b3 + hstep, voffB);
            PG8_WAIT_V(6); PG8_BAR; PG8_MMA(1, 1, At, B1); PG8_BAR;
            }
        }
        if constexpr (ALIGN_EPI) { if (wr == 0) PG8_BAR; }
        if constexpr (!Epi::AFTER_DRAIN) { E(acc, cur, wr, wc, fr, fq); S.done(cur); }
        if (!has_next) break;
#pragma unroll
        for (int a = 0; a < 2; ++a)
#pragma unroll
            for (int b = 0; b < 2; ++b)
#pragma unroll
                for (int m = 0; m < 4; ++m)
#pragma unroll
                    for (int n = 0; n < 2; ++n) acc[a][b][m][n] = (f32x4){0.f, 0.f, 0.f, 0.f};
        cur = nxt; cA = nA; cB = nB; ++ui;
        if constexpr (ALIGN_EPI) { if (wr == 1) PG8_BAR; }
    }
    PG8_WAIT_V(0);
    if constexpr (!ALIGN_EPI) { if (wr == 0) PG8_BAR; }
    PG8_BAR;
    if constexpr (Epi::AFTER_DRAIN) { E.fused(acc, cur, wr, wc, fr, fq, lds, wid, lane); S.done(cur); }
#undef PG8_SA
#undef PG8_SB
#undef PG8_STAGE
#undef PG8_LDA
#undef PG8_LDB
#undef PG8_MMA
#undef PG8_WAIT_V
#undef PG8_WAIT_L
#undef PG8_BAR
#undef PG8_SCHED
}
}

#ifndef PG8_SP2
#define PG8_SP2 true
#endif
#ifndef PG8_ALIGN
#define PG8_ALIGN true
#endif

constexpr int NWAVES = 8;
#ifndef MK_N_LAUNCHES
#define MK_N_LAUNCHES 1
#endif
constexpr int N_LAUNCHES = MK_N_LAUNCHES;

constexpr int BATCH = 4, T = 4096, D = 1024, FF = 4096, PLE = 256;
constexpr int M = BATCH * T;
constexpr int CONVD = 512, RWD = 512, NH = 8, HD = 64, RANK_W = 64, RANK_A = 64, RANK_G = 160;
constexpr int CONV_COLS = 3 * CONVD;
constexpr int RW_COLS = 3 * RWD + RANK_W + RANK_A + RANK_G;
constexpr int IN_COLS = CONV_COLS + RW_COLS;
constexpr int IN_PAD = 3584;
constexpr int PROJ_LD = IN_COLS;
constexpr int C_R = CONV_COLS, C_K = CONV_COLS + RWD, C_V = CONV_COLS + 2 * RWD, C_XW = CONV_COLS + 3 * RWD, C_XA = C_XW + RANK_W, C_XG = C_XA + RANK_A;
constexpr float RMS_EPS = 1e-6f, GN_EPS = 64e-5f, L2_EPS = 1e-12f;
constexpr int CH = 64, NCH = T / CH;

constexpr size_t MiB = 1u << 20;
constexpr size_t WS_CTL = 0, CTL_ZERO_BYTES = 64 * 1024;
constexpr size_t WS_WIN = 1 * MiB, WS_WOUT = 8 * MiB, WS_WUP = 10 * MiB, WS_WDN = 18 * MiB, WS_WG = 26 * MiB, WS_WPLE = 28 * MiB;
constexpr size_t WS_WL = 28 * MiB + 512 * 1024, WS_AL = WS_WL + 64 * 1024, WS_GL = WS_AL + 64 * 1024;
constexpr size_t WS_SSQ1 = 29 * MiB, WS_SSQ2 = WS_SSQ1 + 256 * 1024, WS_SSQ3 = WS_SSQ2 + 256 * 1024;
constexpr size_t WS_CB = 30 * MiB;
constexpr size_t WS_PB = 31 * MiB;
constexpr size_t WS_ABUF = 39 * MiB;
constexpr size_t WS_PLE = 71 * MiB;
constexpr size_t WS_MIX = 103 * MiB;
constexpr size_t WS_PROJ = 135 * MiB;
constexpr size_t WS_HSQ = 128 * MiB;
constexpr size_t WS_SB = 240 * MiB;
constexpr size_t WS_END = 256 * MiB;
static_assert(WS_PROJ + (size_t)M * PROJ_LD * 2 <= WS_SB && WS_HSQ + (size_t)M * FF * 2 <= WS_END && WS_GL + 512 * 160 * 2 <= WS_SSQ1, "d_ws map");
constexpr int CW_BAR = 1024;

constexpr int SLOT = 9216, NSLOT = 16, MLD = 72;
constexpr int RING_BYTES = 131072;
constexpr int LDSCTL_OFF = SLOT * NSLOT;
constexpr int LDS_BYTES = LDSCTL_OFF + 1024;

#define GAS __attribute__((address_space(1)))
#define LAS __attribute__((address_space(3)))
#define DI __device__ __forceinline__
typedef unsigned short bf16;
typedef unsigned v4u __attribute__((ext_vector_type(4)));
typedef unsigned v2u __attribute__((ext_vector_type(2)));
typedef float f32x4 __attribute__((ext_vector_type(4)));
typedef short bf16x8 __attribute__((ext_vector_type(8)));
typedef GAS unsigned gu32;
#define RLX_AGENT __ATOMIC_RELAXED, __HIP_MEMORY_SCOPE_AGENT
#define LDS_WAIT() asm volatile("s_waitcnt lgkmcnt(0)" ::: "memory")
#define VM_WAIT() asm volatile("s_waitcnt vmcnt(0)" ::: "memory")
DI unsigned f2bf(float f) { unsigned u = __builtin_bit_cast(unsigned, f); return (u + 0x7fffu + ((u >> 16) & 1u)) >> 16; }
DI unsigned pk2(float lo, float hi) { return f2bf(lo) | (f2bf(hi) << 16); }
DI float bflo(unsigned w) { return __uint_as_float(w << 16); }
DI float bfhi(unsigned w) { return __uint_as_float(w & 0xffff0000u); }
DI void unpack8(const v4u w, float (&o)[8]) { o[0] = bflo(w.x); o[1] = bfhi(w.x); o[2] = bflo(w.y); o[3] = bfhi(w.y); o[4] = bflo(w.z); o[5] = bfhi(w.z); o[6] = bflo(w.w); o[7] = bfhi(w.w); }
DI v4u pack8(const float (&v)[8]) { v4u w; w.x = pk2(v[0], v[1]); w.y = pk2(v[2], v[3]); w.z = pk2(v[4], v[5]); w.w = pk2(v[6], v[7]); return w; }
DI float sigmoidf_(float x) { return 1.0f / (1.0f + __expf(-x)); }
DI float red8(float v) { v += __shfl_xor(v, 1); v += __shfl_xor(v, 2); v += __shfl_xor(v, 4); return v; }


#define XB_TMO      128
#define XB_XCNT(j)  (256  + 64 * (j))
#define XB_XSUB(j)  (1280 + 64 * (j))
#define XB_XGEN(j)  (2304 + 64 * (j))
#define XB_TOP      3328
#define XB_TOPGEN   3392
#define XCD_BAR_WORDS 3456
#define XB_SPIN_CAP (1u << 18)

__device__ __forceinline__ unsigned xb_ld(unsigned* p)              { return __hip_atomic_load(p, __ATOMIC_RELAXED, __HIP_MEMORY_SCOPE_AGENT); }
__device__ __forceinline__ unsigned xb_add(unsigned* p, unsigned v) { return __hip_atomic_fetch_add(p, v, __ATOMIC_RELAXED, __HIP_MEMORY_SCOPE_AGENT); }
__device__ __forceinline__ unsigned xb_xcc_id() { return (unsigned)__builtin_amdgcn_s_getreg((3 << 11) | 20) & 0xFu; }
#define XB_SPIN(cond, bar) do { unsigned _sp = 0; while (cond) { __builtin_amdgcn_s_sleep(1); \
    if ((++_sp & 255u) == 0u) { if (xb_ld(&(bar)[XB_TMO])) break; if (_sp > XB_SPIN_CAP) { atomicAdd(&(bar)[XB_TMO], 1u); break; } } } } while (0)

struct XcdBarrier {
    unsigned* bar; unsigned x;
    volatile LAS unsigned* st;
};

__device__ __forceinline__ XcdBarrier xcd_barrier_post(unsigned* bar, volatile LAS unsigned* st) {
    XcdBarrier b; b.bar = bar; b.x = xb_xcc_id(); b.st = st;
    if (threadIdx.x == 0) (void)xb_add(&bar[XB_XCNT(b.x)], 1u);
    return b;
}
__device__ __forceinline__ void xcd_barrier_complete(unsigned* bar, unsigned x, unsigned& nloc, unsigned& nx) {
    const unsigned G = gridDim.x * gridDim.y * gridDim.z;
    unsigned sum, cnt, mine, sp = 0u;
    for (;;) {
        sum = 0u; cnt = 0u; mine = 0u;
#pragma unroll
        for (unsigned j = 0; j < 16; ++j) { const unsigned c = xb_ld(&bar[XB_XCNT(j)]); sum += c; cnt += (c > 0u) ? 1u : 0u; mine = (j == x) ? c : mine; }
        if (sum == G) break;
        __builtin_amdgcn_s_sleep(1);
        if ((++sp & 255u) == 0u) { if (xb_ld(&bar[XB_TMO])) break; if (sp > XB_SPIN_CAP) { atomicAdd(&bar[XB_TMO], 1u); break; } }
    }
    nloc = mine > 0u ? mine : 1u; nx = cnt > 0u ? cnt : 1u;
}

__device__ __forceinline__ void xcd_barrier(const XcdBarrier& b) {
    asm volatile("s_waitcnt vmcnt(0)" ::: "memory");
    __syncthreads();
    if (threadIdx.x == 0) {
        unsigned* bar = b.bar;
        __builtin_amdgcn_s_waitcnt(0);
        unsigned nloc = b.st[0], nx = b.st[1];
        if (nloc == 0u) { xcd_barrier_complete(bar, b.x, nloc, nx); b.st[0] = nloc; b.st[1] = nx; }
        const unsigned old = xb_add(&bar[XB_XSUB(b.x)], 1u);
        const unsigned gen = old / nloc;
        if (old + 1u == (gen + 1u) * nloc) {
            __builtin_amdgcn_fence(__ATOMIC_RELEASE, "agent");
            asm volatile("s_waitcnt vmcnt(0)" ::: "memory");
            const unsigned og = xb_add(&bar[XB_TOP], 1u);
            const unsigned tg = og / nx;
            if (og + 1u == (tg + 1u) * nx) xb_add(&bar[XB_TOPGEN], 1u);
            else XB_SPIN(xb_ld(&bar[XB_TOPGEN]) == tg, bar);
            __builtin_amdgcn_fence(__ATOMIC_ACQUIRE, "agent");
            xb_add(&bar[XB_XGEN(b.x)], 1u);
            asm volatile("s_waitcnt vmcnt(0)" ::: "memory");
        } else {
            XB_SPIN(xb_ld(&bar[XB_XGEN(b.x)]) == gen, bar);
            __builtin_amdgcn_fence(__ATOMIC_ACQUIRE, "agent");
            asm volatile("s_waitcnt vmcnt(0)" ::: "memory");
        }
    }
    __syncthreads();
}


struct Frame {
    LAS unsigned char* lds;
    volatile LAS unsigned* MISC;
    gu32* ctl;
    int tid, lane, wave;
    int vcu, G;
    unsigned char* ws;
    const float *x, *p, *norm_mix_g, *w_in, *conv_w, *shift_mu, *w_lora_up, *w0, *a_lora_up, *a0, *g_lora_up, *k_k, *k_a, *r_k, *ln_x_g, *ln_x_b, *w_out, *norm_mlp_g, *w_up, *w_down, *norm_ple_g, *w_ple_gate, *w_ple_proj, *norm_final_g;
    float* out;
};
DI float wave_sum(float v) {
#pragma unroll
    for (int o = 1; o < 64; o <<= 1) v += __shfl_xor(v, o);
    return v;
}
DI void p0_transpose_item(const float* W, int K, int N, bf16* WT, int row_off, const float* gk, LAS float* scr, int item, int lane) {
    const int nblk = N / 32, kb = item / nblk, nb = item % nblk, k0 = 64 * kb, n0 = 32 * nb;
#pragma unroll 8
    for (int i = 0; i < 32; ++i) { const int kk = 2 * i + (lane >> 5); float v = W[(size_t)(k0 + kk) * N + n0 + (lane & 31)]; if (gk) v *= gk[k0 + kk]; scr[kk * 33 + (lane & 31)] = v; }
    LDS_WAIT(); asm volatile("" ::: "memory");
    const int c = lane & 7;
#pragma unroll
    for (int j = 0; j < 4; ++j) { const int n = (lane >> 3) + 8 * j; const LAS float* s = scr + (8 * c) * 33 + n;
        v4u o; o.x = pk2(s[0 * 33], s[1 * 33]); o.y = pk2(s[2 * 33], s[3 * 33]); o.z = pk2(s[4 * 33], s[5 * 33]); o.w = pk2(s[6 * 33], s[7 * 33]);
        *(GAS v4u*)(WT + (size_t)(row_off + n0 + n) * K + k0 + 8 * c) = o; }
    LDS_WAIT(); asm volatile("" ::: "memory");
}
DI void rms_row_to_bf16(Frame& F, const float* xrow, const float* g, bf16* orow) {
    const GAS f32x4* xr = (const GAS f32x4*)xrow + F.lane; const GAS f32x4* gr = (const GAS f32x4*)g + F.lane;
    f32x4 v[4]; float s = 0.f;
#pragma unroll
    for (int j = 0; j < 4; ++j) { v[j] = xr[64 * j]; s += (v[j].x * v[j].x + v[j].y * v[j].y) + (v[j].z * v[j].z + v[j].w * v[j].w); }
    const float rstd = rsqrtf(wave_sum(s) * (1.f / D) + RMS_EPS);
    GAS unsigned long long* o8 = (GAS unsigned long long*)orow + F.lane;
#pragma unroll
    for (int j = 0; j < 4; ++j) { const f32x4 gg = gr[64 * j]; o8[64 * j] = (unsigned long long)pk2(v[j].x * rstd * gg.x, v[j].y * rstd * gg.y) | ((unsigned long long)pk2(v[j].z * rstd * gg.z, v[j].w * rstd * gg.w) << 32); }
}
DI void p0_prologue(Frame& F) {
    LAS float* scr = (LAS float*)(F.lds + F.wave * 16384);
    const int gw = F.vcu * NWAVES + F.wave, NGW = F.G * NWAVES;
    bf16* WIN = (bf16*)(F.ws + WS_WIN); bf16* WOUT = (bf16*)(F.ws + WS_WOUT); bf16* WUP = (bf16*)(F.ws + WS_WUP); bf16* WDN = (bf16*)(F.ws + WS_WDN); bf16* WG = (bf16*)(F.ws + WS_WG); bf16* WPLE = (bf16*)(F.ws + WS_WPLE);
    bf16* WL = (bf16*)(F.ws + WS_WL); bf16* AL = (bf16*)(F.ws + WS_AL); bf16* GL = (bf16*)(F.ws + WS_GL);
    constexpr int I_IN = (D / 64) * (IN_COLS / 32), I_OUT = (D / 64) * (D / 32), I_UP = (D / 64) * (FF / 32), I_DN = (FF / 64) * (D / 32), I_G = I_OUT, I_PLE = (PLE / 64) * (D / 32), I_WL = (RANK_W / 64) * (RWD / 32), I_AL = I_WL;
    constexpr int NITEMS = I_IN + I_OUT + I_UP + I_DN + I_G + I_PLE + I_WL + I_AL;
    for (int it = gw; it < NITEMS; it += NGW) {
        int r = it;
        if (r < I_IN) { p0_transpose_item(F.w_in, D, IN_COLS, WIN, 0, nullptr, scr, r, F.lane); continue; } r -= I_IN;
        if (r < I_OUT) { p0_transpose_item(F.w_out, D, D, WOUT, 0, nullptr, scr, r, F.lane); continue; } r -= I_OUT;
        if (r < I_UP) { p0_transpose_item(F.w_up, D, FF, WUP, 0, F.norm_mlp_g, scr, r, F.lane); continue; } r -= I_UP;
        if (r < I_DN) { p0_transpose_item(F.w_down, FF, D, WDN, 0, nullptr, scr, r, F.lane); continue; } r -= I_DN;
        if (r < I_G) { p0_transpose_item(F.w_ple_gate, D, D, WG, 0, F.norm_ple_g, scr, r, F.lane); continue; } r -= I_G;
        if (r < I_PLE) { p0_transpose_item(F.w_ple_proj, PLE, D, WPLE, 0, nullptr, scr, r, F.lane); continue; } r -= I_PLE;
        if (r < I_WL) { p0_transpose_item(F.w_lora_up, RANK_W, RWD, WL, 0, nullptr, scr, r, F.lane); continue; } r -= I_WL;
        p0_transpose_item(F.a_lora_up, RANK_A, RWD, AL, 0, nullptr, scr, r, F.lane);
    }
    const int gt = F.vcu * (NWAVES * 64) + F.tid, NGT = F.G * NWAVES * 64;
    for (int i = gt; i < (IN_PAD - IN_COLS) * D / 8; i += NGT) ((GAS v4u*)(WIN + (size_t)IN_COLS * D))[i] = (v4u){0u, 0u, 0u, 0u};
    for (int i = gt; i < RWD * RANK_G; i += NGT) { const int n = i / RANK_G, rho = i % RANK_G; GL[i] = (bf16)f2bf(F.g_lora_up[(size_t)rho * RWD + n]); }
    bf16* XN = (bf16*)(F.ws + WS_ABUF); bf16* PB = (bf16*)(F.ws + WS_PB);
    for (int m = gw; m < M; m += NGW) {
        rms_row_to_bf16(F, F.x + (size_t)m * D, F.norm_mix_g, XN + (size_t)m * D);
        const f32x4 pv = ((const GAS f32x4*)(F.p + (size_t)m * PLE))[F.lane];
        ((GAS unsigned long long*)(PB + (size_t)m * PLE))[F.lane] = (unsigned long long)pk2(pv.x, pv.y) | ((unsigned long long)pk2(pv.z, pv.w) << 32);
    }
}
DI void final_norm(Frame& F) {
    const int gw = F.vcu * NWAVES + F.wave, NGW = F.G * NWAVES;
    const float* ssq = (const float*)(F.ws + WS_SSQ3);
    const GAS f32x4* gr = (const GAS f32x4*)F.norm_final_g + F.lane;
    f32x4 gg[4];
#pragma unroll
    for (int j = 0; j < 4; ++j) gg[j] = gr[64 * j];
    for (int m = gw; m < M; m += NGW) {
        const f32x4 s4 = *(const GAS f32x4*)(ssq + (size_t)m * 4); const float rstd = rsqrtf(((s4[0] + s4[1]) + (s4[2] + s4[3])) * (1.f / D) + RMS_EPS);
        GAS f32x4* xr = (GAS f32x4*)(F.out + (size_t)m * D) + F.lane;
#pragma unroll
        for (int j = 0; j < 4; ++j) { f32x4 v = xr[64 * j]; v = v * rstd * gg[j]; xr[64 * j] = v; }
    }
}

#define MFMA16(a, b, c) __builtin_amdgcn_mfma_f32_16x16x32_bf16((a), (b), (c), 0, 0, 0)
DI void load_shift8(const bf16* proj, size_t row, bool has_prev, int col, const float* shift_mu, float (&o)[8]) {
    const v4u c = *(const GAS v4u*)(proj + row * PROJ_LD + col);
    v4u p = (v4u){0u, 0u, 0u, 0u}; if (has_prev) p = *(const GAS v4u*)(proj + (row - 1) * PROJ_LD + col);
    const f32x4 m0 = *(const GAS f32x4*)(shift_mu + (col - CONV_COLS)), m1 = *(const GAS f32x4*)(shift_mu + (col - CONV_COLS) + 4);
    float cu[8], pr[8]; unpack8(c, cu); unpack8(p, pr);
    const float mu[8] = {m0[0], m0[1], m0[2], m0[3], m1[0], m1[1], m1[2], m1[3]};
#pragma unroll
    for (int j = 0; j < 8; ++j) o[j] = cu[j] + mu[j] * (pr[j] - cu[j]);
}
DI void ld8f(const float* g, float (&o)[8]) { const f32x4 a = *(const GAS f32x4*)g, b = *(const GAS f32x4*)(g + 4); o[0] = a[0]; o[1] = a[1]; o[2] = a[2]; o[3] = a[3]; o[4] = b[0]; o[5] = b[1]; o[6] = b[2]; o[7] = b[3]; }
DI void lds_ld8f(const LAS float* g, float (&o)[8]) { const f32x4 a = *(const LAS f32x4*)g, b = *(const LAS f32x4*)(g + 4); o[0] = a[0]; o[1] = a[1]; o[2] = a[2]; o[3] = a[3]; o[4] = b[0]; o[5] = b[1]; o[6] = b[2]; o[7] = b[3]; }
DI void lds_st8f(LAS float* g, const float (&v)[8]) { *(LAS f32x4*)g = (f32x4){v[0], v[1], v[2], v[3]}; *(LAS f32x4*)(g + 4) = (f32x4){v[4], v[5], v[6], v[7]}; }
template <int KS> DI void mm_ll(f32x4& acc, const LAS bf16* A, int lda, const LAS bf16* Bt, int ldb, int mt, int nt, int fr, int fq) {
#pragma unroll
    for (int s = 0; s < KS; ++s) { const bf16x8 a = *(const LAS bf16x8*)(A + (mt * 16 + fr) * lda + s * 32 + fq * 8); const bf16x8 b = *(const LAS bf16x8*)(Bt + (nt * 16 + fr) * ldb + s * 32 + fq * 8);
        acc = MFMA16(b, a, acc); }
}
template <int KS> DI void mm_lg(f32x4& acc, const LAS bf16* A, int lda, const bf16* Bt, int ldb, int mt, int nt, int fr, int fq) {
#pragma unroll
    for (int s = 0; s < KS; ++s) { const bf16x8 a = *(const LAS bf16x8*)(A + (mt * 16 + fr) * lda + s * 32 + fq * 8); const bf16x8 b = *(const GAS bf16x8*)(Bt + (size_t)(nt * 16 + fr) * ldb + s * 32 + fq * 8);
        acc = MFMA16(b, a, acc); }
}

DI void rw_prep1(Frame& F, const bf16* proj, int b, int h, int c, LAS bf16* XW, LAS bf16* XA, float (&r8)[8], float (&k8)[8], float (&v8)[8]) {
    const int t = F.tid >> 3, cg = F.tid & 7, tau = c * CH + t; const size_t row = (size_t)b * T + tau; const bool hp = tau > 0;
    load_shift8(proj, row, hp, C_R + h * HD + cg * 8, F.shift_mu, r8);
    load_shift8(proj, row, hp, C_K + h * HD + cg * 8, F.shift_mu, k8);
    load_shift8(proj, row, hp, C_V + h * HD + cg * 8, F.shift_mu, v8);
    float xw[8], xa[8];
    load_shift8(proj, row, hp, C_XW + cg * 8, F.shift_mu, xw);
    load_shift8(proj, row, hp, C_XA + cg * 8, F.shift_mu, xa);
#pragma unroll
    for (int j = 0; j < 8; ++j) xw[j] = tanhf(xw[j]);
    *(LAS v4u*)(XW + t * MLD + cg * 8) = pack8(xw);
    *(LAS v4u*)(XA + t * MLD + cg * 8) = pack8(xa);
}
DI void rw_lora(Frame& F, int h, const LAS bf16* XW, const LAS bf16* XA, LAS float* LW, LAS float* IC) {
    const int mt = F.wave >> 1, nt0 = (F.wave & 1) * 2, fr = F.lane & 15, fq = F.lane >> 4;
    const bf16* WL = (const bf16*)(F.ws + WS_WL) + (size_t)h * HD * RANK_W; const bf16* AL = (const bf16*)(F.ws + WS_AL) + (size_t)h * HD * RANK_A;
#pragma unroll
    for (int q = 0; q < 2; ++q) { const int nt = nt0 + q; const int n0 = nt * 16 + 4 * fq;
        f32x4 aw = (f32x4){0.f, 0.f, 0.f, 0.f}, aa = aw;
        mm_lg<2>(aw, XW, MLD, WL, RANK_W, mt, nt, fr, fq);
        mm_lg<2>(aa, XA, MLD, AL, RANK_A, mt, nt, fr, fq);
        const f32x4 w0v = *(const GAS f32x4*)(F.w0 + h * HD + n0), a0v = *(const GAS f32x4*)(F.a0 + h * HD + n0);
        f32x4 lw, ic;
#pragma unroll
        for (int i = 0; i < 4; ++i) { const float z = aw[i] + w0v[i]; const float xs = -z; const float sp = fmaxf(xs, 0.f) + log1pf(expf(-fabsf(xs))); lw[i] = -expf(-sp - 0.5f); ic[i] = sigmoidf_(aa[i] + a0v[i]); }
        *(LAS f32x4*)(LW + (mt * 16 + fr) * 64 + n0) = lw; *(LAS f32x4*)(IC + (mt * 16 + fr) * 64 + n0) = ic; }
}
constexpr int GLD = 168;
DI void rw_gate_prep(Frame& F, const bf16* proj, int b, int c, LAS bf16* XG) {
    const int t = F.tid >> 3, cg = F.tid & 7, tau = c * CH + t; const size_t row = (size_t)b * T + tau; const bool hp = tau > 0;
#pragma unroll
    for (int q = 0; q < 3; ++q) { const int g8 = cg + 8 * q; if (g8 < RANK_G / 8) { float xg[8]; load_shift8(proj, row, hp, C_XG + g8 * 8, F.shift_mu, xg);
#pragma unroll
        for (int j = 0; j < 8; ++j) xg[j] = sigmoidf_(xg[j]);
        *(LAS v4u*)(XG + t * GLD + g8 * 8) = pack8(xg); } }
}
DI void rw_gate_mm(Frame& F, int h, const LAS bf16* XG, LAS float* Gm) {
    const int mt = F.wave >> 1, nt0 = (F.wave & 1) * 2, fr = F.lane & 15, fq = F.lane >> 4;
    const bf16* GL = (const bf16*)(F.ws + WS_GL) + (size_t)h * HD * RANK_G;
#pragma unroll
    for (int q = 0; q < 2; ++q) { const int nt = nt0 + q; f32x4 ag = (f32x4){0.f, 0.f, 0.f, 0.f};
        mm_lg<5>(ag, XG, GLD, GL, RANK_G, mt, nt, fr, fq);
        *(LAS f32x4*)(Gm + (mt * 16 + fr) * 64 + nt * 16 + 4 * fq) = ag; }
}
DI void rw_out_epi(Frame& F, int b, int h, int c, const float (&y8)[8], const float (&v8)[8], float cb, const float (&g8)[8]) {
    const int t = F.tid >> 3, cg = F.tid & 7; const size_t row = (size_t)b * T + c * CH + t;
    float s = 0.f;
#pragma unroll
    for (int j = 0; j < 8; ++j) s += y8[j];
    const float mean = red8(s) * (1.f / 64.f); float q = 0.f;
#pragma unroll
    for (int j = 0; j < 8; ++j) { const float d = y8[j] - mean; q += d * d; }
    const float rstd = rsqrtf(red8(q) * (1.f / 64.f) + GN_EPS);
    float lg[8], lb[8], o[8]; ld8f(F.ln_x_g + h * HD + cg * 8, lg); ld8f(F.ln_x_b + h * HD + cg * 8, lb);
#pragma unroll
    for (int j = 0; j < 8; ++j) o[j] = ((y8[j] - mean) * rstd * lg[j] + lb[j] + cb * v8[j]) * g8[j];
    bf16* mix = (bf16*)(F.ws + WS_MIX);
    *(GAS v4u*)(mix + row * D + CONVD + h * HD + cg * 8) = pack8(o);
}
DI void conv_phase(Frame& F, int wg_idx, int nwg) {
    const bf16* proj = (const bf16*)(F.ws + WS_PROJ); bf16* mix = (bf16*)(F.ws + WS_MIX);
    const int cg = F.tid & 63, rsub = F.tid >> 6, ch = cg * 8;
    float w0[8], w1[8], w2[8]; ld8f(F.conv_w + ch, w0); ld8f(F.conv_w + CONVD + ch, w1); ld8f(F.conv_w + 2 * CONVD + ch, w2);
    for (int m = wg_idx * 8 + rsub; m < M; m += nwg * 8) {
        const int tau = m % T; const bf16* pr = proj + (size_t)m * PROJ_LD;
        float gb[8], gc[8], hx[8], u0[8], u1[8], u2[8];
        unpack8(*(const GAS v4u*)(pr + ch), gb);
        unpack8(*(const GAS v4u*)(pr + CONVD + ch), gc); unpack8(*(const GAS v4u*)(pr + 2 * CONVD + ch), hx);
#pragma unroll
        for (int j = 0; j < 8; ++j) u2[j] = gc[j] * hx[j];
        if (tau >= 1) { unpack8(*(const GAS v4u*)(pr - PROJ_LD + CONVD + ch), gc); unpack8(*(const GAS v4u*)(pr - PROJ_LD + 2 * CONVD + ch), hx);
#pragma unroll
            for (int j = 0; j < 8; ++j) u1[j] = gc[j] * hx[j]; }
        else {
#pragma unroll
            for (int j = 0; j < 8; ++j) u1[j] = 0.f; }
        if (tau >= 2) { unpack8(*(const GAS v4u*)(pr - 2 * PROJ_LD + CONVD + ch), gc); unpack8(*(const GAS v4u*)(pr - 2 * PROJ_LD + 2 * CONVD + ch), hx);
#pragma unroll
            for (int j = 0; j < 8; ++j) u0[j] = gc[j] * hx[j]; }
        else {
#pragma unroll
            for (int j = 0; j < 8; ++j) u0[j] = 0.f; }
        float o[8];
#pragma unroll
        for (int j = 0; j < 8; ++j) o[j] = gb[j] * (u0[j] * w0[j] + u1[j] * w1[j] + u2[j] * w2[j]);
        *(GAS v4u*)(mix + (size_t)m * D + ch) = pack8(o);
    }
}
#ifndef MK_NAIVE
#define MK_NAIVE 0
#endif
#if MK_NAIVE
DI void rwkv_naive_chain(Frame& F, int chain) {
    const int b = chain / NH, h = chain % NH;
    const bf16* proj = (const bf16*)(F.ws + WS_PROJ);
    LAS float* F0 = (LAS float*)(F.lds);
    LAS float* F1 = F0 + 4096;
    LAS float* FR = F0 + 2 * 4096; LAS float* FK = F0 + 3 * 4096; LAS float* FV = F0 + 4 * 4096; LAS float* FA = F0 + 5 * 4096; LAS float* FB = F0 + 6 * 4096;
    LAS bf16* XW = (LAS bf16*)(F.lds + 7 * 16384); LAS bf16* XA = XW + 64 * MLD;
    LAS bf16* XG = (LAS bf16*)FA;
    LAS float* Gm = FR;
    const int t = F.tid >> 3, cg = F.tid & 7;
    float S[8];
#pragma unroll
    for (int j = 0; j < 8; ++j) S[j] = 0.f;
    float kkw[8], kaw[8], rkw[8]; ld8f(F.k_k + h * HD + cg * 8, kkw); ld8f(F.k_a + h * HD + cg * 8, kaw); ld8f(F.r_k + h * HD + cg * 8, rkw);
    for (int c = 0; c < NCH; ++c) {
        float r8[8], k8[8], v8[8];
        rw_prep1(F, proj, b, h, c, XW, XA, r8, k8, v8);
        LDS_WAIT(); __syncthreads();
        rw_lora(F, h, XW, XA, F0, F1);
        LDS_WAIT(); __syncthreads();
        float lw[8], ic[8]; lds_ld8f(F0 + t * 64 + cg * 8, lw); lds_ld8f(F1 + t * 64 + cg * 8, ic);
        float kk[8], ss = 0.f;
#pragma unroll
        for (int j = 0; j < 8; ++j) { kk[j] = k8[j] * kkw[j]; ss += kk[j] * kk[j]; }
        const float inv = 1.0f / fmaxf(sqrtf(red8(ss)), L2_EPS);
        float kh[8], a8[8], b8[8], w8[8], cbp = 0.f;
#pragma unroll
        for (int j = 0; j < 8; ++j) { const float kn = kk[j] * inv; kh[j] = k8[j] * (1.0f + (ic[j] - 1.0f) * kaw[j]); a8[j] = -kn; b8[j] = kn * ic[j]; w8[j] = expf(lw[j]); cbp += r8[j] * kh[j] * rkw[j]; }
        const float cb = red8(cbp);
        __syncthreads();
        lds_st8f(F0 + t * 64 + cg * 8, w8); lds_st8f(FR + t * 64 + cg * 8, r8); lds_st8f(FK + t * 64 + cg * 8, kh); lds_st8f(FV + t * 64 + cg * 8, v8); lds_st8f(FA + t * 64 + cg * 8, a8); lds_st8f(FB + t * 64 + cg * 8, b8);
        LDS_WAIT(); __syncthreads();
        for (int s = 0; s < CH; ++s) {
            float aa[8], bb[8], ww[8], kx[8], rr[8];
            lds_ld8f(FA + s * 64 + cg * 8, aa); lds_ld8f(FB + s * 64 + cg * 8, bb); lds_ld8f(F0 + s * 64 + cg * 8, ww); lds_ld8f(FK + s * 64 + cg * 8, kx); lds_ld8f(FR + s * 64 + cg * 8, rr);
            const float vi = FV[s * 64 + t];
            float sa = 0.f;
#pragma unroll
            for (int j = 0; j < 8; ++j) sa += S[j] * aa[j];
            sa = red8(sa);
            float y = 0.f;
#pragma unroll
            for (int j = 0; j < 8; ++j) { S[j] = S[j] * ww[j] + sa * bb[j] + vi * kx[j]; y += S[j] * rr[j]; }
            y = red8(y);
            if (cg == 0) F1[s * 64 + t] = y;
        }
        LDS_WAIT(); __syncthreads();
        rw_gate_prep(F, proj, b, c, XG);
        LDS_WAIT(); __syncthreads();
        rw_gate_mm(F, h, XG, Gm);
        LDS_WAIT(); __syncthreads();
        float y8[8], g8[8]; lds_ld8f(F1 + t * 64 + cg * 8, y8); lds_ld8f(Gm + t * 64 + cg * 8, g8);
        rw_out_epi(F, b, h, c, y8, v8, cb, g8);
        __syncthreads();
    }
}

#endif
DI LAS bf16* slotp(Frame& F, int i) { return (LAS bf16*)(F.lds + i * SLOT); }
DI void st_n(LAS bf16* Dst, int mt, int nt, int fr, int fq, const f32x4 v) { v2u w; w.x = pk2(v[0], v[1]); w.y = pk2(v[2], v[3]); *(LAS v2u*)(Dst + (mt * 16 + fr) * MLD + nt * 16 + 4 * fq) = w; }
DI void st_t(LAS bf16* Dst, int mt, int nt, int fr, int fq, const f32x4 v) {
#pragma unroll
    for (int i = 0; i < 4; ++i) Dst[(nt * 16 + 4 * fq + i) * MLD + mt * 16 + fr] = (bf16)f2bf(v[i]); }
DI f32x4 ld_tile(const LAS bf16* Src, int mt, int nt, int fr, int fq) { const v2u w = *(const LAS v2u*)(Src + (mt * 16 + fr) * MLD + nt * 16 + 4 * fq); return (f32x4){bflo(w.x), bfhi(w.x), bflo(w.y), bfhi(w.y)}; }
DI void st_g(bf16* Dst, int mt, int nt, int fr, int fq, const f32x4 v) { v2u w; w.x = pk2(v[0], v[1]); w.y = pk2(v[2], v[3]); *(GAS v2u*)(Dst + (mt * 16 + fr) * 64 + nt * 16 + 4 * fq) = w; }
DI f32x4 ld_g(const bf16* Src, int mt, int nt, int fr, int fq) { const v2u w = *(const GAS v2u*)(Src + (mt * 16 + fr) * 64 + nt * 16 + 4 * fq); return (f32x4){bflo(w.x), bfhi(w.x), bflo(w.y), bfhi(w.y)}; }
template <int KS> DI void mm_gg(f32x4& acc, const bf16* A, int lda, const bf16* Bt, int ldb, int mt, int nt, int fr, int fq) {
#pragma unroll
    for (int s = 0; s < KS; ++s) { const bf16x8 a = *(const GAS bf16x8*)(A + (size_t)(mt * 16 + fr) * lda + s * 32 + fq * 8); const bf16x8 b = *(const GAS bf16x8*)(Bt + (size_t)(nt * 16 + fr) * ldb + s * 32 + fq * 8);
        acc = MFMA16(b, a, acc); }
}
constexpr size_t CHUNK_ELEMS = 64 * 64, NCHUNKS = (size_t)BATCH * NH * NCH;
DI bf16* chunk_PT(Frame& F) { return (bf16*)F.out; }
DI bf16* chunk_Q(Frame& F) { return (bf16*)F.out + NCHUNKS * CHUNK_ELEMS; }
DI bf16* chunk_RW(Frame& F) { return (bf16*)F.out + 2 * NCHUNKS * CHUNK_ELEMS; }
DI bf16* chunk_YP(Frame& F) { return (bf16*)F.out + 3 * NCHUNKS * CHUNK_ELEMS; }
#define BAR() do { LDS_WAIT(); __syncthreads(); } while (0)

DI void rw_chunk_item(Frame& F, int b, int h, int c) {
    const bf16* proj = (const bf16*)(F.ws + WS_PROJ);
    const size_t ci = ((size_t)(b * NH + h) * NCH + c) * CHUNK_ELEMS;
    const int t = F.tid >> 3, cg = F.tid & 7;
    const int mt = F.wave >> 1, nt0 = (F.wave & 1) * 2, fr = F.lane & 15, fq = F.lane >> 4;
    LAS bf16* XW = slotp(F, 0); LAS bf16* XA = slotp(F, 1); LAS float* LW = (LAS float*)slotp(F, 2); LAS float* IC = (LAS float*)slotp(F, 4); LAS float* SEG = (LAS float*)slotp(F, 14);
    LAS float* GC = (LAS float*)(F.lds + LDSCTL_OFF + 512);
    LAS bf16* sAt = slotp(F, 6); LAS bf16* sAtT = slotp(F, 7); LAS bf16* sRt = slotp(F, 8); LAS bf16* sBt = slotp(F, 9); LAS bf16* sKt = slotp(F, 10); LAS bf16* sBhT = slotp(F, 11); LAS bf16* sKhT = slotp(F, 12); LAS bf16* sVt = slotp(F, 13);
    float r8[8], k8[8], v8[8];
    rw_prep1(F, proj, b, h, c, XW, XA, r8, k8, v8);
    BAR();
    rw_lora(F, h, XW, XA, LW, IC);
    BAR();
    {
        const int seg = F.wave, kc = F.lane; float pfx[8]; float run = 0.f;
#pragma unroll
        for (int j = 0; j < 8; ++j) { run += LW[(seg * 8 + j) * 64 + kc]; pfx[j] = run; }
        SEG[seg * 64 + kc] = run;
        BAR();
        float off = 0.f;
#pragma unroll
        for (int s = 0; s < 8; ++s) { const float sv = SEG[s * 64 + kc]; off += (s < seg) ? sv : 0.f; }
#pragma unroll
        for (int j = 0; j < 8; ++j) LW[(seg * 8 + j) * 64 + kc] = pfx[j] + off;
        BAR();
    }
    {
        float Lt[8], Lm[8], LC[8], ic[8];
        lds_ld8f(LW + t * 64 + cg * 8, Lt); lds_ld8f(LW + 63 * 64 + cg * 8, LC); lds_ld8f(IC + t * 64 + cg * 8, ic);
        if (t > 0) lds_ld8f(LW + (t - 1) * 64 + cg * 8, Lm); else {
#pragma unroll
            for (int j = 0; j < 8; ++j) Lm[j] = 0.f; }
        float kkw[8], kaw[8], rkw[8]; ld8f(F.k_k + h * HD + cg * 8, kkw); ld8f(F.k_a + h * HD + cg * 8, kaw); ld8f(F.r_k + h * HD + cg * 8, rkw);
        float kk[8], ss = 0.f;
#pragma unroll
        for (int j = 0; j < 8; ++j) { kk[j] = k8[j] * kkw[j]; ss += kk[j] * kk[j]; }
        const float inv = 1.0f / fmaxf(sqrtf(red8(ss)), L2_EPS);
        float at[8], rt[8], bt[8], kt[8], bh[8], khh[8], cbp = 0.f;
#pragma unroll
        for (int j = 0; j < 8; ++j) { const float kn = kk[j] * inv; const float kh = k8[j] * (1.0f + (ic[j] - 1.0f) * kaw[j]); const float bb = kn * ic[j];
            const float em = expf(Lm[j]), et = expf(Lt[j]), en = expf(-Lt[j]), ec = expf(LC[j] - Lt[j]);
            at[j] = -kn * em; rt[j] = r8[j] * et; bt[j] = bb * en; kt[j] = kh * en; bh[j] = bb * ec; khh[j] = kh * ec; cbp += r8[j] * kh * rkw[j]; }
        const float cb = red8(cbp);
        if (cg == 0) ((float*)(F.ws + WS_CB))[((size_t)b * T + c * CH + t) * NH + h] = cb;
        if (t == 63) {
#pragma unroll
            for (int j = 0; j < 8; ++j) GC[cg * 8 + j] = expf(LC[j]); }
        *(LAS v4u*)(sAt + t * MLD + cg * 8) = pack8(at); *(LAS v4u*)(sRt + t * MLD + cg * 8) = pack8(rt); *(LAS v4u*)(sBt + t * MLD + cg * 8) = pack8(bt); *(LAS v4u*)(sKt + t * MLD + cg * 8) = pack8(kt);
#pragma unroll
        for (int j = 0; j < 8; ++j) { const int kc = cg * 8 + j; sAtT[kc * MLD + t] = (bf16)f2bf(at[j]); sBhT[kc * MLD + t] = (bf16)f2bf(bh[j]); sKhT[kc * MLD + t] = (bf16)f2bf(khh[j]); sVt[kc * MLD + t] = (bf16)f2bf(v8[j]); }
    }
    BAR();
    LAS bf16* sN = slotp(F, 0); LAS bf16* sNT = slotp(F, 1); LAS bf16* sT0 = slotp(F, 2); LAS bf16* sAak = slotp(F, 3); LAS bf16* sArb = slotp(F, 4); LAS bf16* sArk = slotp(F, 5);
#pragma unroll
    for (int q = 0; q < 2; ++q) { const int nt = nt0 + q; const f32x4 z = (f32x4){0.f, 0.f, 0.f, 0.f};
        f32x4 ab = z, ak = z, rb = z, rk = z;
        if (nt <= mt) { mm_ll<2>(ab, sAt, MLD, sBt, MLD, mt, nt, fr, fq); mm_ll<2>(ak, sAt, MLD, sKt, MLD, mt, nt, fr, fq); mm_ll<2>(rb, sRt, MLD, sBt, MLD, mt, nt, fr, fq); mm_ll<2>(rk, sRt, MLD, sKt, MLD, mt, nt, fr, fq); }
        const int m = mt * 16 + fr; f32x4 t0;
#pragma unroll
        for (int i = 0; i < 4; ++i) { const int n = nt * 16 + 4 * fq + i; if (!(n < m)) { ab[i] = 0.f; ak[i] = 0.f; } if (!(n <= m)) { rb[i] = 0.f; rk[i] = 0.f; } t0[i] = ab[i] + ((n == m) ? 1.0f : 0.f); }
        st_n(sN, mt, nt, fr, fq, ab); st_t(sNT, mt, nt, fr, fq, ab); st_n(sT0, mt, nt, fr, fq, t0); st_n(sAak, mt, nt, fr, fq, ak); st_n(sArb, mt, nt, fr, fq, rb); st_n(sArk, mt, nt, fr, fq, rk); }
    BAR();
    LAS bf16* sM1T = slotp(F, 9);
#pragma unroll
    for (int q = 0; q < 2; ++q) { const int nt = nt0 + q; f32x4 n2 = (f32x4){0.f, 0.f, 0.f, 0.f}, m1 = n2;
        mm_ll<2>(n2, sN, MLD, sNT, MLD, mt, nt, fr, fq); mm_ll<2>(m1, sAak, MLD, sVt, MLD, mt, nt, fr, fq);
        st_n(slotp(F, 15), mt, nt, fr, fq, n2); st_t(slotp(F, 6), mt, nt, fr, fq, n2); st_t(sM1T, mt, nt, fr, fq, m1); }
    BAR();
    for (int it = 1; it <= 5; ++it) {
        const bool odd = it & 1;
        const LAS bf16* cT = slotp(F, odd ? 2 : 14); const LAS bf16* cNp = slotp(F, odd ? 15 : 0); const LAS bf16* cNpT = slotp(F, odd ? 6 : 1);
        LAS bf16* dT = slotp(F, odd ? 14 : 2); LAS bf16* dNp = slotp(F, odd ? 0 : 15); LAS bf16* dNpT = slotp(F, odd ? 1 : 6);
#pragma unroll
        for (int q = 0; q < 2; ++q) { const int nt = nt0 + q; f32x4 tn = ld_tile(cT, mt, nt, fr, fq);
            mm_ll<2>(tn, cT, MLD, cNpT, MLD, mt, nt, fr, fq); st_n(dT, mt, nt, fr, fq, tn);
            if (it < 5) { f32x4 n2 = (f32x4){0.f, 0.f, 0.f, 0.f}; mm_ll<2>(n2, cNp, MLD, cNpT, MLD, mt, nt, fr, fq); st_n(dNp, mt, nt, fr, fq, n2); st_t(dNpT, mt, nt, fr, fq, n2); } }
        BAR();
    }
    LAS bf16* sTm = slotp(F, 14); LAS bf16* sWT = slotp(F, 0); LAS bf16* sUT = slotp(F, 1);
#pragma unroll
    for (int q = 0; q < 2; ++q) { const int nt = nt0 + q; f32x4 w = (f32x4){0.f, 0.f, 0.f, 0.f}, u = w;
        mm_ll<2>(w, sTm, MLD, sAtT, MLD, mt, nt, fr, fq); mm_ll<2>(u, sTm, MLD, sM1T, MLD, mt, nt, fr, fq);
        st_t(sWT, mt, nt, fr, fq, w); st_t(sUT, mt, nt, fr, fq, u); }
    BAR();
    bf16* gPT = chunk_PT(F) + ci; bf16* gQ = chunk_Q(F) + ci; bf16* gRW = chunk_RW(F) + ci; bf16* gYP = chunk_YP(F) + ci;
#pragma unroll
    for (int q = 0; q < 2; ++q) { const int nt = nt0 + q; const f32x4 z = (f32x4){0.f, 0.f, 0.f, 0.f};
        f32x4 pt = z, qq = z, rw = ld_tile(sRt, mt, nt, fr, fq), yp = z;
        mm_ll<2>(pt, sBhT, MLD, sWT, MLD, mt, nt, fr, fq);
        const int m = mt * 16 + fr;
#pragma unroll
        for (int i = 0; i < 4; ++i) { const int n = nt * 16 + 4 * fq + i; if (n == m) pt[i] += GC[m]; }
        mm_ll<2>(qq, sUT, MLD, sBhT, MLD, mt, nt, fr, fq); mm_ll<2>(qq, sVt, MLD, sKhT, MLD, mt, nt, fr, fq);
        mm_ll<2>(rw, sArb, MLD, sWT, MLD, mt, nt, fr, fq);
        mm_ll<2>(yp, sArb, MLD, sUT, MLD, mt, nt, fr, fq); mm_ll<2>(yp, sArk, MLD, sVt, MLD, mt, nt, fr, fq);
        st_g(gPT, mt, nt, fr, fq, pt); st_g(gQ, mt, nt, fr, fq, qq); st_g(gRW, mt, nt, fr, fq, rw); st_g(gYP, mt, nt, fr, fq, yp); }
    BAR();
}
DI void rw_scan_chain(Frame& F, int chain) {
    const int mt = F.wave >> 1, nt0 = (F.wave & 1) * 2, fr = F.lane & 15, fq = F.lane >> 4;
    bf16* SB = (bf16*)(F.ws + WS_SB) + (size_t)chain * NCH * CHUNK_ELEMS;
    const bf16* gPT = chunk_PT(F) + (size_t)chain * NCH * CHUNK_ELEMS; const bf16* gQ = chunk_Q(F) + (size_t)chain * NCH * CHUNK_ELEMS;
    LAS bf16* S0 = slotp(F, 0); LAS bf16* S1 = slotp(F, 1);
    const f32x4 z = (f32x4){0.f, 0.f, 0.f, 0.f};
#pragma unroll
    for (int q = 0; q < 2; ++q) { st_n(S0, mt, nt0 + q, fr, fq, z); st_g(SB, mt, nt0 + q, fr, fq, z); }
    BAR();
    bf16x8 pb[2][2]; v2u qv[2];
#pragma unroll
    for (int q = 0; q < 2; ++q) { const int nt = nt0 + q;
#pragma unroll
        for (int s = 0; s < 2; ++s) pb[q][s] = *(const GAS bf16x8*)(gPT + (size_t)(nt * 16 + fr) * 64 + s * 32 + fq * 8);
        qv[q] = *(const GAS v2u*)(gQ + (mt * 16 + fr) * 64 + nt * 16 + 4 * fq); }
    for (int c = 0; c < NCH - 1; ++c) {
        const LAS bf16* cur = (c & 1) ? S1 : S0; LAS bf16* nxt = (c & 1) ? S0 : S1;
        bf16x8 pn[2][2]; v2u qn[2];
        const int cn = (c + 1 < NCH - 1) ? c + 1 : c;
#pragma unroll
        for (int q = 0; q < 2; ++q) { const int nt = nt0 + q;
#pragma unroll
            for (int s = 0; s < 2; ++s) pn[q][s] = *(const GAS bf16x8*)(gPT + (size_t)cn * CHUNK_ELEMS + (size_t)(nt * 16 + fr) * 64 + s * 32 + fq * 8);
            qn[q] = *(const GAS v2u*)(gQ + (size_t)cn * CHUNK_ELEMS + (mt * 16 + fr) * 64 + nt * 16 + 4 * fq); }
        bf16x8 a[2];
#pragma unroll
        for (int s = 0; s < 2; ++s) a[s] = *(const LAS bf16x8*)(cur + (mt * 16 + fr) * MLD + s * 32 + fq * 8);
#pragma unroll
        for (int q = 0; q < 2; ++q) { const int nt = nt0 + q; f32x4 acc = (f32x4){bflo(qv[q].x), bfhi(qv[q].x), bflo(qv[q].y), bfhi(qv[q].y)};
#pragma unroll
            for (int s = 0; s < 2; ++s) acc = MFMA16(pb[q][s], a[s], acc);
            st_n(nxt, mt, nt, fr, fq, acc); st_g(SB + (size_t)(c + 1) * CHUNK_ELEMS, mt, nt, fr, fq, acc); }
        BAR();
#pragma unroll
        for (int q = 0; q < 2; ++q) { qv[q] = qn[q];
#pragma unroll
            for (int s = 0; s < 2; ++s) pb[q][s] = pn[q][s]; }
    }
}
DI void rw_out_item(Frame& F, int b, int h, int c) {
    const bf16* proj = (const bf16*)(F.ws + WS_PROJ);
    const size_t ci = ((size_t)(b * NH + h) * NCH + c) * CHUNK_ELEMS;
    const int t = F.tid >> 3, cg = F.tid & 7;
    const int mt = F.wave >> 1, nt0 = (F.wave & 1) * 2, fr = F.lane & 15, fq = F.lane >> 4;
    LAS bf16* XG = slotp(F, 0); LAS float* Yf = (LAS float*)slotp(F, 3); LAS float* Gf = (LAS float*)slotp(F, 5);
    rw_gate_prep(F, proj, b, c, XG);
    const bf16* gRW = chunk_RW(F) + ci; const bf16* gYP = chunk_YP(F) + ci; const bf16* gS = (const bf16*)(F.ws + WS_SB) + ci;
#pragma unroll
    for (int q = 0; q < 2; ++q) { const int nt = nt0 + q; f32x4 y = ld_g(gYP, mt, nt, fr, fq);
        mm_gg<2>(y, gRW, 64, gS, 64, mt, nt, fr, fq);
        *(LAS f32x4*)(Yf + (mt * 16 + fr) * 64 + nt * 16 + 4 * fq) = y; }
    BAR();
    rw_gate_mm(F, h, XG, Gf);
    BAR();
    float y8[8], g8[8], v8[8]; lds_ld8f(Yf + t * 64 + cg * 8, y8); lds_ld8f(Gf + t * 64 + cg * 8, g8);
    const int tau = c * CH + t; const size_t row = (size_t)b * T + tau;
    load_shift8(proj, row, tau > 0, C_V + h * HD + cg * 8, F.shift_mu, v8);
    const float cb = ((const float*)(F.ws + WS_CB))[row * NH + h];
    rw_out_epi(F, b, h, c, y8, v8, cb, g8);
    BAR();
}

constexpr int NPH = 10;
struct Args { const float* in[24]; float* out; unsigned char* ws; int ph_lo, ph_hi, li, pad; };
__global__ void __launch_bounds__(NWAVES * 64, 2) mk_fwd(Args args) {
    extern __shared__ __attribute__((aligned(16))) unsigned char lds[];
    Frame F;
    F.lds = (LAS unsigned char*)lds;
    F.MISC = (volatile LAS unsigned*)(F.lds + LDSCTL_OFF);
    F.tid = threadIdx.x; F.lane = F.tid & 63; F.wave = __builtin_amdgcn_readfirstlane(F.tid >> 6);
    F.G = gridDim.x; { const int bx = blockIdx.x; F.vcu = (F.G % 8 == 0) ? (bx % 8) * (F.G / 8) + bx / 8 : bx; }
    F.ws = args.ws; F.ctl = (gu32*)(args.ws + WS_CTL); F.out = args.out;
    F.x = args.in[0]; F.p = args.in[1]; F.norm_mix_g = args.in[2]; F.w_in = args.in[3]; F.conv_w = args.in[4]; F.shift_mu = args.in[5]; F.w_lora_up = args.in[6]; F.w0 = args.in[7];
    F.a_lora_up = args.in[8]; F.a0 = args.in[9]; F.g_lora_up = args.in[10]; F.k_k = args.in[11]; F.k_a = args.in[12]; F.r_k = args.in[13]; F.ln_x_g = args.in[14]; F.ln_x_b = args.in[15];
    F.w_out = args.in[16]; F.norm_mlp_g = args.in[17]; F.w_up = args.in[18]; F.w_down = args.in[19]; F.norm_ple_g = args.in[20]; F.w_ple_gate = args.in[21]; F.w_ple_proj = args.in[22]; F.norm_final_g = args.in[23];
    for (int u = F.tid; u < (LDS_BYTES - LDSCTL_OFF) / 4; u += NWAVES * 64) ((LAS unsigned*)(F.lds + LDSCTL_OFF))[u] = 0u;
    __syncthreads();
    XcdBarrier bar; bar.bar = (unsigned*)(F.ctl + CW_BAR) + args.li * XCD_BAR_WORDS; bar.x = 0; bar.st = nullptr;
    if (N_LAUNCHES == 1) bar = xcd_barrier_post((unsigned*)(F.ctl + CW_BAR), F.MISC + 8);
    const int lo = args.ph_lo, hi = args.ph_hi;
#define IN(k) (lo <= (k) && (k) < hi)
#define SEAM(k) do { if (IN(k) && IN((k) + 1)) xcd_barrier(bar); } while (0)
    bf16* ABUF = (bf16*)(F.ws + WS_ABUF); bf16* PROJ = (bf16*)(F.ws + WS_PROJ); bf16* MIX = (bf16*)(F.ws + WS_MIX); bf16* PLEB = (bf16*)(F.ws + WS_PLE); bf16* HSQ = (bf16*)(F.ws + WS_HSQ); bf16* PB = (bf16*)(F.ws + WS_PB);
    float* SSQ1 = (float*)(F.ws + WS_SSQ1); float* SSQ2 = (float*)(F.ws + WS_SSQ2); float* SSQ3 = (float*)(F.ws + WS_SSQ3);

    if (IN(0)) { p0_prologue(F); } SEAM(0);
    if (IN(1)) {
        { pg8::Gemm g{ABUF, (const bf16*)(F.ws + WS_WIN), M, IN_PAD, D}; pg8::StaticOrder S; S.init(M, IN_PAD, F.G, (int)blockIdx.x);
          pg8::EpiBf16G E{PROJ, PROJ_LD, IN_COLS};
          pg8::gemm_phase<pg8::EpiBf16G, pg8::StaticOrder, PG8_ALIGN, PG8_SP2>(F.lds, g, S, E); }
        { pg8::Gemm g{PB, (const bf16*)(F.ws + WS_WPLE), M, D, PLE}; pg8::StaticOrder S; S.init(M, D, F.G, (int)blockIdx.x);
          pg8::EpiBf16G E{PLEB, D, D};
          pg8::gemm_phase<pg8::EpiBf16G, pg8::StaticOrder, PG8_ALIGN, PG8_SP2>(F.lds, g, S, E); }
    } SEAM(1);
#if MK_NAIVE
    if (IN(2)) {
        if (F.vcu < BATCH * NH) rwkv_naive_chain(F, F.vcu);
        else conv_phase(F, F.vcu - BATCH * NH, F.G - BATCH * NH);
    } SEAM(2); SEAM(3); SEAM(4);
#else
    if (IN(2)) { for (int item = F.vcu; item < BATCH * NCH * NH; item += F.G) { const int h = item % NH, bc = item / NH; rw_chunk_item(F, bc / NCH, h, bc % NCH); } } SEAM(2);
    if (IN(3)) {
        if (F.vcu < BATCH * NH) rw_scan_chain(F, F.vcu);
        else conv_phase(F, F.vcu - BATCH * NH, F.G - BATCH * NH);
    } SEAM(3);
    if (IN(4)) { for (int item = F.vcu; item < BATCH * NCH * NH; item += F.G) { const int h = item % NH, bc = item / NH; rw_out_item(F, bc / NCH, h, bc % NCH); } } SEAM(4);
#endif
    if (IN(5)) {
        pg8::Gemm g{MIX, (const bf16*)(F.ws + WS_WOUT), M, D, D}; pg8::StaticOrder S; S.init(M, D, F.G, (int)blockIdx.x);
        pg8::EpiRes E{F.x, F.out, ABUF, SSQ1, D};
        pg8::gemm_phase<pg8::EpiRes, pg8::StaticOrder, false, PG8_SP2>(F.lds, g, S, E);
    } SEAM(5);
    if (IN(6)) {
        pg8::Gemm g{ABUF, (const bf16*)(F.ws + WS_WUP), M, FF, D}; pg8::StaticOrder S; S.init(M, FF, F.G, (int)blockIdx.x);
        pg8::EpiSqRelu E{HSQ, FF, SSQ1, 1.f / D, RMS_EPS};
        pg8::gemm_phase<pg8::EpiSqRelu, pg8::StaticOrder, PG8_ALIGN, PG8_SP2>(F.lds, g, S, E);
    } SEAM(6);
    if (IN(7)) {
        pg8::Gemm g{HSQ, (const bf16*)(F.ws + WS_WDN), M, D, FF}; pg8::StaticOrder S; S.init(M, D, F.G, (int)blockIdx.x);
        pg8::EpiRes E{F.out, F.out, ABUF, SSQ2, D};
        pg8::gemm_phase<pg8::EpiRes, pg8::StaticOrder, false, PG8_SP2>(F.lds, g, S, E);
    } SEAM(7);
    if (IN(8)) {
        pg8::Gemm g{ABUF, (const bf16*)(F.ws + WS_WG), M, D, D}; pg8::StaticOrder S; S.init(M, D, F.G, (int)blockIdx.x);
        pg8::EpiGate E{F.out, PLEB, SSQ2, SSQ3, D, 1.f / D, RMS_EPS};
        pg8::gemm_phase<pg8::EpiGate, pg8::StaticOrder, false, PG8_SP2>(F.lds, g, S, E);
    } SEAM(8);
    if (IN(9)) { final_norm(F); }
#undef IN
#undef SEAM
}

extern "C" void kernel_launch(void* const* d_in, const int* in_sizes, int n_in, void* d_out, int out_size, void* d_ws, size_t ws_size, hipStream_t stream) {
    static int grid = 0;
    if (grid == 0) {
        if (n_in != 24 || in_sizes[0] != M * D || out_size != M * D || ws_size < WS_END) { fprintf(stderr, "kernel_launch: unexpected shapes: n_in %d in0 %d out %d ws %zu\n", n_in, n_in > 0 ? in_sizes[0] : -1, out_size, ws_size); grid = -1; return; }
        int dev = 0, cus = 0, per_cu = 0;
        if (hipGetDevice(&dev) != hipSuccess || hipDeviceGetAttribute(&cus, hipDeviceAttributeMultiprocessorCount, dev) != hipSuccess) { fprintf(stderr, "kernel_launch: device query failed\n"); grid = -1; return; }
        if (hipFuncSetAttribute((const void*)mk_fwd, hipFuncAttributeMaxDynamicSharedMemorySize, LDS_BYTES) != hipSuccess) { fprintf(stderr, "kernel_launch: hipFuncSetAttribute failed\n"); grid = -1; return; }
        if (hipOccupancyMaxActiveBlocksPerMultiprocessor(&per_cu, (const void*)mk_fwd, NWAVES * 64, LDS_BYTES) != hipSuccess || per_cu < 1)
            fprintf(stderr, "kernel_launch: note: occupancy query reports %d workgroups per CU\n", per_cu);
        (void)hipGetLastError();
        grid = cus;
        if (grid != 256) { fprintf(stderr, "kernel_launch: this kernel needs a 256-CU device (got %d)\n", grid); grid = -1; return; }
    }
    if (grid < 0) return;
    if (hipMemsetAsync((char*)d_ws + WS_CTL, 0, CTL_ZERO_BYTES, stream) != hipSuccess) { fprintf(stderr, "kernel_launch: hipMemsetAsync failed\n"); return; }
    Args a{};
    for (int i = 0; i < 24; ++i) a.in[i] = (const float*)d_in[i];
    a.out = (float*)d_out; a.ws = (unsigned char*)d_ws;
    if (N_LAUNCHES == 1) { a.ph_lo = 0; a.ph_hi = NPH; a.li = 0; hipLaunchKernelGGL(mk_fwd, dim3(grid), dim3(NWAVES * 64), LDS_BYTES, stream, a); }
    else for (int li = 0; li < NPH; ++li) { a.ph_lo = li; a.ph_hi = li + 1; a.li = 0; hipLaunchKernelGGL(mk_fwd, dim3(grid), dim3(NWAVES * 64), LDS_BYTES, stream, a); }
    const hipError_t le = hipPeekAtLastError();
    if (le != hipSuccess) fprintf(stderr, "kernel_launch: launch failed: %s\n", hipGetErrorName(le));
}
```

```cpp
#include <hip/hip_runtime.h>
#include <cstdio>
#include <cstdint>

namespace pg8 {
#define PG8_LAS __attribute__((address_space(3)))
typedef unsigned short bf16_t;
typedef short bf16x8 __attribute__((ext_vector_type(8)));
typedef float f32x4 __attribute__((ext_vector_type(4)));
typedef unsigned u32x4 __attribute__((ext_vector_type(4)));
constexpr int BM = 256, BK = 64, HALF = 128, HTB = HALF * BK * 2  , STAGE_BYTES = 8 * HTB, NXCD = 8, WGM = 8;

__host__ __device__ __forceinline__ int lds_byte(int r, int c) { const int st = (r >> 4) * 2 + (c >> 5), rr = r & 15, cc = c & 31, ob = rr * 64 + cc * 2; return st * 1024 + (ob ^ (((ob >> 9) & 1) << 5)); }
__host__ __device__ __forceinline__ void stage_rc(int b, int& R, int& C) { const int st = b / 1024, sb = b % 1024, swz = sb ^ (((sb >> 9) & 1) << 5); R = (st >> 1) * 16 + swz / 64; C = (st & 1) * 32 + (swz % 64) / 2; }
__host__ __device__ __forceinline__ int perm32(int rho) { const int n = rho >> 4, i = rho & 15; return 8 * (i >> 2) + 4 * n + (i & 3); }

struct Unit { int pm, pn; };
struct Gemm { const bf16_t* A; const bf16_t* Bt; int M, N, K; };

struct StaticOrder {
    int nM, nN, nwg, G, c;
    __host__ __device__ void init(int M, int N, int G_, int c_) { nM = M / BM; nN = N / BM; nwg = nM * nN; G = G_; c = c_; }
    __host__ __device__ bool next(int i, Unit& u) const {
        const long L = (long)i * G + c; if (L >= nwg) return false;
        int wgid = (int)L; { const int q = nwg / NXCD, r = nwg % NXCD, xcd = wgid % NXCD, off = wgid / NXCD; wgid = (xcd < r ? xcd * (q + 1) : r * (q + 1) + (xcd - r) * q) + off; }
        const int nig = WGM * nN, gid = wgid / nig, fm = gid * WGM, gsz = (nM - fm) < WGM ? (nM - fm) : WGM;
        u.pm = fm + ((wgid % nig) % gsz); u.pn = (wgid % nig) / gsz; return true;
    }
    __device__ __forceinline__ void a_ready(const Unit&) const {}
    __device__ __forceinline__ void done(const Unit&) const {}
};

__device__ __forceinline__ unsigned cvt_pk_bf16(float lo, float hi) { unsigned r; asm volatile("v_cvt_pk_bf16_f32 %0, %1, %2" : "=v"(r) : "v"(lo), "v"(hi)); return r; }
typedef float f32x2 __attribute__((ext_vector_type(2)));

typedef unsigned u32x2 __attribute__((ext_vector_type(2)));
struct EpiBf16G {
    static constexpr bool PERM = true, AFTER_DRAIN = false;
    bf16_t* O; int ldc; int ncols;
    __device__ __forceinline__ void operator()(const f32x4 (&acc)[2][2][4][2], const Unit& u, int wr, int wc, int fr, int fq) const {
        const int row0 = u.pm * BM + wr * 64 + fr, col0 = u.pn * BM + wc * 32 + 8 * fq;
#pragma unroll
        for (int ai = 0; ai < 2; ++ai)
#pragma unroll
            for (int m = 0; m < 4; ++m) { bf16_t* rowp = O + (size_t)(row0 + ai * HALF + m * 16) * ldc + col0;
#pragma unroll
                for (int bj = 0; bj < 2; ++bj) { if (col0 + bj * HALF < ncols) { const f32x4 v0 = acc[ai][bj][m][0], v1 = acc[ai][bj][m][1];
                    u32x4 w; w.x = cvt_pk_bf16(v0[0], v0[1]); w.y = cvt_pk_bf16(v0[2], v0[3]); w.z = cvt_pk_bf16(v1[0], v1[1]); w.w = cvt_pk_bf16(v1[2], v1[3]);
                    *(u32x4*)(rowp + bj * HALF) = w; } } }
    }
};
struct EpiSqRelu {
    static constexpr bool PERM = true, AFTER_DRAIN = false;
    bf16_t* O; int ldc; const float* ssq; float inv_n, eps;
    __device__ __forceinline__ void operator()(const f32x4 (&acc)[2][2][4][2], const Unit& u, int wr, int wc, int fr, int fq) const {
        const int row0 = u.pm * BM + wr * 64 + fr, col0 = u.pn * BM + wc * 32 + 8 * fq;
#pragma unroll
        for (int ai = 0; ai < 2; ++ai)
#pragma unroll
            for (int m = 0; m < 4; ++m) { const int row = row0 + ai * HALF + m * 16; bf16_t* rowp = O + (size_t)row * ldc + col0;
                const f32x4 s4 = *(const f32x4*)(ssq + (size_t)row * 4); const float rs = rsqrtf(((s4[0] + s4[1]) + (s4[2] + s4[3])) * inv_n + eps);
#pragma unroll
                for (int bj = 0; bj < 2; ++bj) { f32x4 v0 = acc[ai][bj][m][0] * rs, v1 = acc[ai][bj][m][1] * rs;
#pragma unroll
                    for (int e = 0; e < 4; ++e) { const float a = fmaxf(v0[e], 0.f), b = fmaxf(v1[e], 0.f); v0[e] = a * a; v1[e] = b * b; }
                    u32x4 w; w.x = cvt_pk_bf16(v0[0], v0[1]); w.y = cvt_pk_bf16(v0[2], v0[3]); w.z = cvt_pk_bf16(v1[0], v1[1]); w.w = cvt_pk_bf16(v1[2], v1[3]);
                    *(u32x4*)(rowp + bj * HALF) = w; } }
    }
};
struct EpiRes {
    static constexpr bool PERM = false, AFTER_DRAIN = true;
    const float* base; float* out; bf16_t* hb; float* ssq; int ldc;
    __device__ __forceinline__ void fused(f32x4 (&acc)[2][2][4][2], const Unit& u, int wr, int wc, int fr, int fq, PG8_LAS unsigned char* lds, int wid, int lane) const {
        PG8_LAS float* P = (PG8_LAS float*)lds;
        const int col0 = u.pn * BM + wc * 32 + 4 * fq;
#pragma unroll
        for (int ai = 0; ai < 2; ++ai)
#pragma unroll
            for (int m = 0; m < 4; ++m) { const int r = ai * HALF + wr * 64 + m * 16 + fr; const size_t off = (size_t)(u.pm * BM + r) * ldc + col0; float ss = 0.f;
#pragma unroll
                for (int bj = 0; bj < 2; ++bj)
#pragma unroll
                    for (int n = 0; n < 2; ++n) { const size_t o2 = off + bj * HALF + n * 16; const f32x4 bs = *(const f32x4*)(base + o2); const f32x4 h = bs + acc[ai][bj][m][n];
                        *(f32x4*)(out + o2) = h; ss += (h[0] * h[0] + h[1] * h[1]) + (h[2] * h[2] + h[3] * h[3]);
                        u32x2 w; w.x = cvt_pk_bf16(h[0], h[1]); w.y = cvt_pk_bf16(h[2], h[3]); *(u32x2*)(hb + o2) = w; }
                ss += __shfl_xor(ss, 16); ss += __shfl_xor(ss, 32);
                if (fq == 0) P[r * 4 + wc] = ss;
                asm volatile("" ::: "memory"); }
        asm volatile("s_waitcnt lgkmcnt(0)" ::: "memory"); __builtin_amdgcn_s_barrier(); asm volatile("" ::: "memory");
        const int tid = wid * 64 + lane;
        if (tid < 256) { const f32x4 p = *(const PG8_LAS f32x4*)(P + tid * 4); ssq[(size_t)(u.pm * BM + tid) * 4 + u.pn] = (p[0] + p[1]) + (p[2] + p[3]); }
        asm volatile("s_waitcnt lgkmcnt(0)" ::: "memory"); __builtin_amdgcn_s_barrier(); asm volatile("" ::: "memory");
    }
};
struct EpiGate {
    static constexpr bool PERM = false, AFTER_DRAIN = true;
    float* io; const bf16_t* ple; const float* ssq_in; float* ssq_out; int ldc; float inv_n, eps;
    __device__ __forceinline__ void fused(f32x4 (&acc)[2][2][4][2], const Unit& u, int wr, int wc, int fr, int fq, PG8_LAS unsigned char* lds, int wid, int lane) const {
        PG8_LAS float* P = (PG8_LAS float*)lds;
        const int col0 = u.pn * BM + wc * 32 + 4 * fq;
#pragma unroll
        for (int ai = 0; ai < 2; ++ai)
#pragma unroll
            for (int m = 0; m < 4; ++m) { const int r = ai * HALF + wr * 64 + m * 16 + fr; const size_t off = (size_t)(u.pm * BM + r) * ldc + col0; float ss = 0.f;
                const f32x4 s4 = *(const f32x4*)(ssq_in + (size_t)(u.pm * BM + r) * 4); const float rs = rsqrtf(((s4[0] + s4[1]) + (s4[2] + s4[3])) * inv_n + eps);
#pragma unroll
                for (int bj = 0; bj < 2; ++bj)
#pragma unroll
                    for (int n = 0; n < 2; ++n) { const size_t o2 = off + bj * HALF + n * 16; const f32x4 h2 = *(const f32x4*)(io + o2); const u32x2 pw = *(const u32x2*)(ple + o2);
                        f32x4 pl; pl[0] = __uint_as_float(pw.x << 16); pl[1] = __uint_as_float(pw.x & 0xffff0000u); pl[2] = __uint_as_float(pw.y << 16); pl[3] = __uint_as_float(pw.y & 0xffff0000u);
                        f32x4 h; const f32x4 a = acc[ai][bj][m][n] * rs;
#pragma unroll
                        for (int e = 0; e < 4; ++e) { const float g = 1.0f / (1.0f + __expf(-a[e])); h[e] = h2[e] + g * pl[e]; }
                        *(f32x4*)(io + o2) = h; ss += (h[0] * h[0] + h[1] * h[1]) + (h[2] * h[2] + h[3] * h[3]); }
                ss += __shfl_xor(ss, 16); ss += __shfl_xor(ss, 32);
                if (fq == 0) P[r * 4 + wc] = ss;
                asm volatile("" ::: "memory"); }
        asm volatile("s_waitcnt lgkmcnt(0)" ::: "memory"); __builtin_amdgcn_s_barrier(); asm volatile("" ::: "memory");
        const int tid = wid * 64 + lane;
        if (tid < 256) { const f32x4 p = *(const PG8_LAS f32x4*)(P + tid * 4); ssq_out[(size_t)(u.pm * BM + tid) * 4 + u.pn] = (p[0] + p[1]) + (p[2] + p[3]); }
        asm volatile("s_waitcnt lgkmcnt(0)" ::: "memory"); __builtin_amdgcn_s_barrier(); asm volatile("" ::: "memory");
    }
};


template <class Epi, class Sched, bool ALIGN_EPI = false, bool SP2 = false>
__device__ __forceinline__ void gemm_phase(PG8_LAS unsigned char* lds, const Gemm g, const Sched& S, const Epi& E) {
    const int tid = threadIdx.x, wid = __builtin_amdgcn_readfirstlane(tid >> 6), lane = tid & 63, wr = wid >> 2, wc = wid & 3, fr = lane & 15, fq = lane >> 4;
    const int K = g.K, nt = K / BK;
    unsigned voffA[2], voffB[2];
#pragma unroll
    for (int i = 0; i < 2; ++i) { int R, C; stage_rc(tid * 16 + i * 8192, R, C); const int Rb = Epi::PERM ? ((R & ~31) + perm32(R & 31)) : R;
        voffA[i] = (unsigned)(R * K + C) * 2u; voffB[i] = (unsigned)(Rb * K + C) * 2u; }
    const size_t kstep = (size_t)(BK * 2);
    const size_t hstep = (size_t)HALF * K * 2;
    const size_t tstep = 2 * hstep;
    const unsigned ldsw = (unsigned)wid * 1024u;
    const int aoff = lds_byte(wr * 64 + fr, fq * 8), boff = lds_byte(wc * 32 + fr, fq * 8);
#define PG8_SA(b, h) (((b) * 2 + (h)) * HTB)
#define PG8_SB(b, h) ((4 + (b) * 2 + (h)) * HTB)
#define PG8_STAGE(bufoff, gbase, voff) do { _Pragma("unroll") for (int _i = 0; _i < 2; ++_i) \
        __builtin_amdgcn_global_load_lds((const unsigned*)((const char*)(gbase) + (voff)[_i]), (PG8_LAS unsigned*)(lds + (bufoff) + ldsw + _i * 8192), 16, 0, 0); } while (0)
#define PG8_LDA(dst, b, h) do { _Pragma("unroll") for (int m = 0; m < 4; ++m) _Pragma("unroll") for (int k = 0; k < 2; ++k) dst[m][k] = *(const PG8_LAS bf16x8*)(lds + PG8_SA(b, h) + aoff + m * 2048 + k * 1024); } while (0)
#define PG8_LDB(dst, b, h) do { _Pragma("unroll") for (int n = 0; n < 2; ++n) _Pragma("unroll") for (int k = 0; k < 2; ++k) dst[n][k] = *(const PG8_LAS bf16x8*)(lds + PG8_SB(b, h) + boff + n * 2048 + k * 1024); } while (0)
#define PG8_MMA(ai, bj, At, Bt) do { __builtin_amdgcn_s_setprio(1); _Pragma("unroll") for (int m = 0; m < 4; ++m) _Pragma("unroll") for (int n = 0; n < 2; ++n) _Pragma("unroll") for (int k = 0; k < 2; ++k) \
        acc[ai][bj][m][n] = __builtin_amdgcn_mfma_f32_16x16x32_bf16(Bt[n][k], At[m][k], acc[ai][bj][m][n], 0, 0, 0); __builtin_amdgcn_s_setprio(0); } while (0)
#define PG8_WAIT_V(n) asm volatile("s_waitcnt vmcnt(" #n ")" ::: "memory")
#define PG8_WAIT_L(n) asm volatile("s_waitcnt lgkmcnt(" #n ")" ::: "memory")
#define PG8_BAR __builtin_amdgcn_s_barrier()
#define PG8_SCHED __builtin_amdgcn_sched_barrier(0)
    Unit cur, nxt; int ui = 0;
    if (!S.next(0, cur)) return;
    f32x4 acc[2][2][4][2];
#pragma unroll
    for (int a = 0; a < 2; ++a)
#pragma unroll
        for (int b = 0; b < 2; ++b)
#pragma unroll
            for (int m = 0; m < 4; ++m)
#pragma unroll
                for (int n = 0; n < 2; ++n) acc[a][b][m][n] = (f32x4){0.f, 0.f, 0.f, 0.f};
    bf16x8 At[4][2], B0[2][2], B1[2][2];
    const char* cA = (const char*)g.A + (size_t)cur.pm * tstep; const char* cB = (const char*)g.Bt + (size_t)cur.pn * tstep;
    S.a_ready(cur);
    if constexpr (SP2) {
        PG8_STAGE(PG8_SB(0, 0), cB, voffB); PG8_STAGE(PG8_SB(0, 1), cB + hstep, voffB); PG8_STAGE(PG8_SA(0, 0), cA, voffA); PG8_STAGE(PG8_SA(0, 1), cA + hstep, voffA);
        if (wr == 1) PG8_BAR;
        PG8_WAIT_V(2); PG8_BAR;
        PG8_STAGE(PG8_SB(1, 0), cB + kstep, voffB); PG8_STAGE(PG8_SA(1, 0), cA + kstep, voffA); PG8_STAGE(PG8_SB(1, 1), cB + hstep + kstep, voffB);
        PG8_WAIT_V(6); PG8_BAR;
    } else {
        PG8_STAGE(PG8_SB(0, 0), cB, voffB); PG8_STAGE(PG8_SA(0, 0), cA, voffA); PG8_STAGE(PG8_SB(0, 1), cB + hstep, voffB); PG8_STAGE(PG8_SA(0, 1), cA + hstep, voffA);
        if (wr == 1) PG8_BAR;
        PG8_WAIT_V(4); PG8_BAR;
        PG8_STAGE(PG8_SB(1, 0), cB + kstep, voffB); PG8_STAGE(PG8_SA(1, 0), cA + kstep, voffA); PG8_STAGE(PG8_SB(1, 1), cB + hstep + kstep, voffB);
        PG8_WAIT_V(6); PG8_BAR;
    }
    for (;;) {
        const bool has_next = S.next(ui + 1, nxt);
        const char* nA = has_next ? (const char*)g.A + (size_t)nxt.pm * tstep : cA; const char* nB = has_next ? (const char*)g.Bt + (size_t)nxt.pn * tstep : cB;
        for (int t = 0; t < nt; t += 2) {
            const bool last = (t == nt - 2);
            const char* a1 = cA + (size_t)(t + 1) * kstep;
            const char* a2 = last ? nA : cA + (size_t)(t + 2) * kstep; const char* b2 = last ? nB : cB + (size_t)(t + 2) * kstep;
            const char* a3 = a2 + kstep; const char* b3 = b2 + kstep;
            if (last && has_next) S.a_ready(nxt);
            if constexpr (SP2) {
            PG8_LDB(B0, 0, 0); PG8_LDB(B1, 0, 1); PG8_SCHED; PG8_LDA(At, 0, 0); PG8_STAGE(PG8_SA(1, 1), a1 + hstep, voffA);
            PG8_WAIT_V(8); PG8_WAIT_L(0); PG8_BAR; PG8_MMA(0, 0, At, B0); PG8_MMA(0, 1, At, B1); PG8_BAR; PG8_SCHED;
            PG8_LDA(At, 0, 1); PG8_STAGE(PG8_SB(0, 0), b2, voffB); PG8_STAGE(PG8_SB(0, 1), b2 + hstep, voffB); PG8_STAGE(PG8_SA(0, 0), a2, voffA);
            PG8_WAIT_V(8); PG8_WAIT_L(0); PG8_BAR; PG8_MMA(1, 0, At, B0); PG8_MMA(1, 1, At, B1); PG8_BAR; PG8_SCHED;
            PG8_LDB(B0, 1, 0); PG8_LDB(B1, 1, 1); PG8_SCHED; PG8_LDA(At, 1, 0); PG8_STAGE(PG8_SA(0, 1), a2 + hstep, voffA);
            PG8_WAIT_V(8); PG8_WAIT_L(0); PG8_BAR; PG8_MMA(0, 0, At, B0); PG8_MMA(0, 1, At, B1); PG8_BAR; PG8_SCHED;
            PG8_LDA(At, 1, 1); PG8_STAGE(PG8_SB(1, 0), b3, voffB); PG8_STAGE(PG8_SB(1, 1), b3 + hstep, voffB); PG8_STAGE(PG8_SA(1, 0), a3, voffA);
            PG8_WAIT_V(8); PG8_WAIT_L(0); PG8_BAR; PG8_MMA(1, 0, At, B0); PG8_MMA(1, 1, At, B1); PG8_BAR; PG8_SCHED;
            } else {
            PG8_LDB(B0, 0, 0); PG8_SCHED; PG8_LDA(At, 0, 0); PG8_STAGE(PG8_SA(1, 1), a1 + hstep, voffA);
            PG8_WAIT_L(8); PG8_BAR; PG8_WAIT_L(0); PG8_MMA(0, 0, At, B0); PG8_BAR; PG8_SCHED;
            PG8_LDB(B1, 0, 1); PG8_STAGE(PG8_SB(0, 0), b2, voffB);
            PG8_BAR; PG8_WAIT_L(0); PG8_MMA(0, 1, At, B1); PG8_BAR;
            PG8_LDA(At, 0, 1); PG8_STAGE(PG8_SA(0, 0), a2, voffA);
            PG8_BAR; PG8_WAIT_L(0); PG8_MMA(1, 0, At, B0); PG8_BAR; PG8_SCHED;
            PG8_STAGE(PG8_SB(0, 1), b2 + hstep, voffB);
            PG8_WAIT_V(6); PG8_BAR; PG8_MMA(1, 1, At, B1); PG8_BAR;
            PG8_LDB(B0, 1, 0); PG8_SCHED; PG8_LDA(At, 1, 0); PG8_STAGE(PG8_SA(0, 1), a2 + hstep, voffA);
            PG8_WAIT_L(8); PG8_BAR; PG8_WAIT_L(0); PG8_MMA(0, 0, At, B0); PG8_BAR; PG8_SCHED;
            PG8_LDB(B1, 1, 1); PG8_STAGE(PG8_SB(1, 0), b3, voffB);
            PG8_BAR; PG8_WAIT_L(0); PG8_MMA(0, 1, At, B1); PG8_BAR;
            PG8_LDA(At, 1, 1); PG8_STAGE(PG8_SA(1, 0), a3, voffA);
            PG8_BAR; PG8_WAIT_L(0); PG8_MMA(1, 0, At, B0); PG8_BAR; PG8_SCHED;
            PG8_STAGE(PG8_SB(1, 1), b3 + hstep, voffB);
            PG8_WAIT_V(6); PG8_BAR; PG8_MMA(1, 1, At, B1); PG8_BAR;
            }
        }
        if constexpr (ALIGN_EPI) { if (wr == 0) PG8_BAR; }
        if constexpr (!Epi::AFTER_DRAIN) { E(acc, cur, wr, wc, fr, fq); S.done(cur); }
        if (!has_next) break;
#pragma unroll
        for (int a = 0; a < 2; ++a)
#pragma unroll
            for (int b = 0; b < 2; ++b)
#pragma unroll
                for (int m = 0; m < 4; ++m)
#pragma unroll
                    for (int n = 0; n < 2; ++n) acc[a][b][m][n] = (f32x4){0.f, 0.f, 0.f, 0.f};
        cur = nxt; cA = nA; cB = nB; ++ui;
        if constexpr (ALIGN_EPI) { if (wr == 1) PG8_BAR; }
    }
    PG8_WAIT_V(0);
    if constexpr (!ALIGN_EPI) { if (wr == 0) PG8_BAR; }
    PG8_BAR;
    if constexpr (Epi::AFTER_DRAIN) { E.fused(acc, cur, wr, wc, fr, fq, lds, wid, lane); S.done(cur); }
#undef PG8_SA
#undef PG8_SB
#undef PG8_STAGE
#undef PG8_LDA
#undef PG8_LDB
#undef PG8_MMA
#undef PG8_WAIT_V
#undef PG8_WAIT_L
#undef PG8_BAR
#undef PG8_SCHED
}
}

#ifndef PG8_SP2
#define PG8_SP2 true
#endif
#ifndef PG8_ALIGN
#define PG8_ALIGN true
#endif

#ifndef MK_XIT
#define MK_XIT 0
#endif
#ifndef MK_XM5
#define MK_XM5 0
#endif
constexpr int NWAVES = 8;
#ifndef MK_N_LAUNCHES
#define MK_N_LAUNCHES 1
#endif
constexpr int N_LAUNCHES = MK_N_LAUNCHES;

constexpr int BATCH = 4, T = 4096, D = 1024, FF = 4096, PLE = 256;
constexpr int M = BATCH * T;
constexpr int CONVD = 512, RWD = 512, NH = 8, HD = 64, RANK_W = 64, RANK_A = 64, RANK_G = 160;
constexpr int CONV_COLS = 3 * CONVD;
constexpr int RW_COLS = 3 * RWD + RANK_W + RANK_A + RANK_G;
constexpr int IN_COLS = CONV_COLS + RW_COLS;
constexpr int IN_PAD = 3584;
constexpr int PROJ_LD = IN_COLS;
constexpr int C_R = CONV_COLS, C_K = CONV_COLS + RWD, C_V = CONV_COLS + 2 * RWD, C_XW = CONV_COLS + 3 * RWD, C_XA = C_XW + RANK_W, C_XG = C_XA + RANK_A;
constexpr float RMS_EPS = 1e-6f, GN_EPS = 64e-5f, L2_EPS = 1e-12f;
constexpr int CH = 64, NCH = T / CH;

constexpr size_t MiB = 1u << 20;
constexpr size_t WS_CTL = 0, CTL_ZERO_BYTES = 64 * 1024;
constexpr size_t WS_WIN = 1 * MiB, WS_WOUT = 8 * MiB, WS_WUP = 10 * MiB, WS_WDN = 18 * MiB, WS_WG = 26 * MiB, WS_WPLE = 28 * MiB;
constexpr size_t WS_WL = 28 * MiB + 512 * 1024, WS_AL = WS_WL + 64 * 1024, WS_GL = WS_AL + 64 * 1024;
constexpr size_t WS_SSQ1 = 29 * MiB, WS_SSQ2 = WS_SSQ1 + 256 * 1024, WS_SSQ3 = WS_SSQ2 + 256 * 1024;
constexpr size_t WS_CB = 30 * MiB;
constexpr size_t WS_PB = 31 * MiB;
constexpr size_t WS_ABUF = 39 * MiB;
constexpr size_t WS_PLE = 71 * MiB;
constexpr size_t WS_MIX = 103 * MiB;
constexpr size_t WS_PROJ = 135 * MiB;
constexpr size_t WS_HSQ = 128 * MiB;
constexpr size_t WS_SB = 240 * MiB;
constexpr size_t WS_END = 256 * MiB;
static_assert(WS_PROJ + (size_t)M * PROJ_LD * 2 <= WS_SB && WS_HSQ + (size_t)M * FF * 2 <= WS_END && WS_GL + 512 * 160 * 2 <= WS_SSQ1, "d_ws map");
constexpr int CW_BAR = 1024;

constexpr int SLOT = 9216, NSLOT = 16, MLD = 72;
constexpr int RING_BYTES = 131072;
constexpr int LDSCTL_OFF = SLOT * NSLOT;
constexpr int LDS_BYTES = LDSCTL_OFF + 1024 + 12288;

#define GAS __attribute__((address_space(1)))
#define LAS __attribute__((address_space(3)))
#define DI __device__ __forceinline__
typedef unsigned short bf16;
typedef unsigned v4u __attribute__((ext_vector_type(4)));
typedef unsigned v2u __attribute__((ext_vector_type(2)));
typedef float f32x4 __attribute__((ext_vector_type(4)));
typedef short bf16x8 __attribute__((ext_vector_type(8)));
typedef GAS unsigned gu32;
#define RLX_AGENT __ATOMIC_RELAXED, __HIP_MEMORY_SCOPE_AGENT
#define LDS_WAIT() asm volatile("s_waitcnt lgkmcnt(0)" ::: "memory")
#define VM_WAIT() asm volatile("s_waitcnt vmcnt(0)" ::: "memory")
DI unsigned f2bf(float f) { unsigned u = __builtin_bit_cast(unsigned, f); return (u + 0x7fffu + ((u >> 16) & 1u)) >> 16; }
typedef __bf16 hbf16x2 __attribute__((ext_vector_type(2)));
typedef float f32x2v __attribute__((ext_vector_type(2)));
DI unsigned pk2(float lo, float hi) { const f32x2v f = {lo, hi}; return __builtin_bit_cast(unsigned, __builtin_convertvector(f, hbf16x2)); }
DI float bflo(unsigned w) { return __uint_as_float(w << 16); }
DI float bfhi(unsigned w) { return __uint_as_float(w & 0xffff0000u); }
DI void unpack8(const v4u w, float (&o)[8]) { o[0] = bflo(w.x); o[1] = bfhi(w.x); o[2] = bflo(w.y); o[3] = bfhi(w.y); o[4] = bflo(w.z); o[5] = bfhi(w.z); o[6] = bflo(w.w); o[7] = bfhi(w.w); }
DI v4u pack8(const float (&v)[8]) { v4u w; w.x = pk2(v[0], v[1]); w.y = pk2(v[2], v[3]); w.z = pk2(v[4], v[5]); w.w = pk2(v[6], v[7]); return w; }
DI float sigmoidf_(float x) { return 1.0f / (1.0f + __expf(-x)); }
DI float red8(float v) { v += __shfl_xor(v, 1); v += __shfl_xor(v, 2); v += __shfl_xor(v, 4); return v; }


#define XB_TMO      128
#define XB_XCNT(j)  (256  + 64 * (j))
#define XB_XSUB(j)  (1280 + 64 * (j))
#define XB_XGEN(j)  (2304 + 64 * (j))
#define XB_TOP      3328
#define XB_TOPGEN   3392
#define XCD_BAR_WORDS 3456
#define XB_SPIN_CAP (1u << 18)

__device__ __forceinline__ unsigned xb_ld(unsigned* p)              { return __hip_atomic_load(p, __ATOMIC_RELAXED, __HIP_MEMORY_SCOPE_AGENT); }
__device__ __forceinline__ unsigned xb_add(unsigned* p, unsigned v) { return __hip_atomic_fetch_add(p, v, __ATOMIC_RELAXED, __HIP_MEMORY_SCOPE_AGENT); }
__device__ __forceinline__ unsigned xb_xcc_id() { return (unsigned)__builtin_amdgcn_s_getreg((3 << 11) | 20) & 0xFu; }
#define XB_SPIN(cond, bar) do { unsigned _sp = 0; while (cond) { __builtin_amdgcn_s_sleep(1); \
    if ((++_sp & 255u) == 0u) { if (xb_ld(&(bar)[XB_TMO])) break; if (_sp > XB_SPIN_CAP) { atomicAdd(&(bar)[XB_TMO], 1u); break; } } } } while (0)

struct XcdBarrier {
    unsigned* bar; unsigned x;
    volatile LAS unsigned* st;
};

__device__ __forceinline__ XcdBarrier xcd_barrier_post(unsigned* bar, volatile LAS unsigned* st) {
    XcdBarrier b; b.bar = bar; b.x = xb_xcc_id(); b.st = st;
    if (threadIdx.x == 0) (void)xb_add(&bar[XB_XCNT(b.x)], 1u);
    return b;
}
__device__ __forceinline__ void xcd_barrier_complete(unsigned* bar, unsigned x, unsigned& nloc, unsigned& nx) {
    const unsigned G = gridDim.x * gridDim.y * gridDim.z;
    unsigned sum, cnt, mine, sp = 0u;
    for (;;) {
        sum = 0u; cnt = 0u; mine = 0u;
#pragma unroll
        for (unsigned j = 0; j < 16; ++j) { const unsigned c = xb_ld(&bar[XB_XCNT(j)]); sum += c; cnt += (c > 0u) ? 1u : 0u; mine = (j == x) ? c : mine; }
        if (sum == G) break;
        __builtin_amdgcn_s_sleep(1);
        if ((++sp & 255u) == 0u) { if (xb_ld(&bar[XB_TMO])) break; if (sp > XB_SPIN_CAP) { atomicAdd(&bar[XB_TMO], 1u); break; } }
    }
    nloc = mine > 0u ? mine : 1u; nx = cnt > 0u ? cnt : 1u;
}

__device__ __forceinline__ void xcd_barrier(const XcdBarrier& b) {
    asm volatile("s_waitcnt vmcnt(0)" ::: "memory");
    __syncthreads();
    if (threadIdx.x == 0) {
        unsigned* bar = b.bar;
        __builtin_amdgcn_s_waitcnt(0);
        unsigned nloc = b.st[0], nx = b.st[1];
        if (nloc == 0u) { xcd_barrier_complete(bar, b.x, nloc, nx); b.st[0] = nloc; b.st[1] = nx; }
        const unsigned old = xb_add(&bar[XB_XSUB(b.x)], 1u);
        const unsigned gen = old / nloc;
        if (old + 1u == (gen + 1u) * nloc) {
            __builtin_amdgcn_fence(__ATOMIC_RELEASE, "agent");
            asm volatile("s_waitcnt vmcnt(0)" ::: "memory");
            const unsigned og = xb_add(&bar[XB_TOP], 1u);
            const unsigned tg = og / nx;
            if (og + 1u == (tg + 1u) * nx) xb_add(&bar[XB_TOPGEN], 1u);
            else XB_SPIN(xb_ld(&bar[XB_TOPGEN]) == tg, bar);
            __builtin_amdgcn_fence(__ATOMIC_ACQUIRE, "agent");
            xb_add(&bar[XB_XGEN(b.x)], 1u);
            asm volatile("s_waitcnt vmcnt(0)" ::: "memory");
        } else {
            XB_SPIN(xb_ld(&bar[XB_XGEN(b.x)]) == gen, bar);
            __builtin_amdgcn_fence(__ATOMIC_ACQUIRE, "agent");
            asm volatile("s_waitcnt vmcnt(0)" ::: "memory");
        }
    }
    __syncthreads();
}


struct Frame {
    LAS unsigned char* lds;
    volatile LAS unsigned* MISC;
    gu32* ctl;
    int tid, lane, wave;
    int vcu, G;
    unsigned char* ws;
    const float *x, *p, *norm_mix_g, *w_in, *conv_w, *shift_mu, *w_lora_up, *w0, *a_lora_up, *a0, *g_lora_up, *k_k, *k_a, *r_k, *ln_x_g, *ln_x_b, *w_out, *norm_mlp_g, *w_up, *w_down, *norm_ple_g, *w_ple_gate, *w_ple_proj, *norm_final_g;
    float* out;
};
DI float wave_sum(float v) {
#pragma unroll
    for (int o = 1; o < 64; o <<= 1) v += __shfl_xor(v, o);
    return v;
}
DI void p0_transpose_item(const float* W, int K, int N, bf16* WT, int row_off, const float* gk, LAS float* scr, int item, int lane) {
    const int nblk = N / 32, kb = item / nblk, nb = item % nblk, k0 = 64 * kb, n0 = 32 * nb;
#pragma unroll 8
    for (int i = 0; i < 32; ++i) { const int kk = 2 * i + (lane >> 5); float v = W[(size_t)(k0 + kk) * N + n0 + (lane & 31)]; if (gk) v *= gk[k0 + kk]; scr[kk * 33 + (lane & 31)] = v; }
    LDS_WAIT(); asm volatile("" ::: "memory");
    const int c = lane & 7;
#pragma unroll
    for (int j = 0; j < 4; ++j) { const int n = (lane >> 3) + 8 * j; const LAS float* s = scr + (8 * c) * 33 + n;
        v4u o; o.x = pk2(s[0 * 33], s[1 * 33]); o.y = pk2(s[2 * 33], s[3 * 33]); o.z = pk2(s[4 * 33], s[5 * 33]); o.w = pk2(s[6 * 33], s[7 * 33]);
        *(GAS v4u*)(WT + (size_t)(row_off + n0 + n) * K + k0 + 8 * c) = o; }
    LDS_WAIT(); asm volatile("" ::: "memory");
}
DI void rms_row_to_bf16(Frame& F, const float* xrow, const float* g, bf16* orow) {
    const GAS f32x4* xr = (const GAS f32x4*)xrow + F.lane; const GAS f32x4* gr = (const GAS f32x4*)g + F.lane;
    f32x4 v[4]; float s = 0.f;
#pragma unroll
    for (int j = 0; j < 4; ++j) { v[j] = xr[64 * j]; s += (v[j].x * v[j].x + v[j].y * v[j].y) + (v[j].z * v[j].z + v[j].w * v[j].w); }
    const float rstd = rsqrtf(wave_sum(s) * (1.f / D) + RMS_EPS);
    GAS unsigned long long* o8 = (GAS unsigned long long*)orow + F.lane;
#pragma unroll
    for (int j = 0; j < 4; ++j) { const f32x4 gg = gr[64 * j]; o8[64 * j] = (unsigned long long)pk2(v[j].x * rstd * gg.x, v[j].y * rstd * gg.y) | ((unsigned long long)pk2(v[j].z * rstd * gg.z, v[j].w * rstd * gg.w) << 32); }
}
DI void p0_prologue(Frame& F) {
    LAS float* scr = (LAS float*)(F.lds + F.wave * 16384);
    const int gw = F.vcu * NWAVES + F.wave, NGW = F.G * NWAVES;
    bf16* WIN = (bf16*)(F.ws + WS_WIN); bf16* WOUT = (bf16*)(F.ws + WS_WOUT); bf16* WUP = (bf16*)(F.ws + WS_WUP); bf16* WDN = (bf16*)(F.ws + WS_WDN); bf16* WG = (bf16*)(F.ws + WS_WG); bf16* WPLE = (bf16*)(F.ws + WS_WPLE);
    bf16* WL = (bf16*)(F.ws + WS_WL); bf16* AL = (bf16*)(F.ws + WS_AL); bf16* GL = (bf16*)(F.ws + WS_GL);
    constexpr int I_IN = (D / 64) * (IN_COLS / 32), I_OUT = (D / 64) * (D / 32), I_UP = (D / 64) * (FF / 32), I_DN = (FF / 64) * (D / 32), I_G = I_OUT, I_PLE = (PLE / 64) * (D / 32), I_WL = (RANK_W / 64) * (RWD / 32), I_AL = I_WL;
    constexpr int NITEMS = I_IN + I_OUT + I_UP + I_DN + I_G + I_PLE + I_WL + I_AL;
    for (int it = gw; it < NITEMS; it += NGW) {
        int r = it;
        if (r < I_IN) { p0_transpose_item(F.w_in, D, IN_COLS, WIN, 0, nullptr, scr, r, F.lane); continue; } r -= I_IN;
        if (r < I_OUT) { p0_transpose_item(F.w_out, D, D, WOUT, 0, nullptr, scr, r, F.lane); continue; } r -= I_OUT;
        if (r < I_UP) { p0_transpose_item(F.w_up, D, FF, WUP, 0, F.norm_mlp_g, scr, r, F.lane); continue; } r -= I_UP;
        if (r < I_DN) { p0_transpose_item(F.w_down, FF, D, WDN, 0, nullptr, scr, r, F.lane); continue; } r -= I_DN;
        if (r < I_G) { p0_transpose_item(F.w_ple_gate, D, D, WG, 0, F.norm_ple_g, scr, r, F.lane); continue; } r -= I_G;
        if (r < I_PLE) { p0_transpose_item(F.w_ple_proj, PLE, D, WPLE, 0, nullptr, scr, r, F.lane); continue; } r -= I_PLE;
        if (r < I_WL) { p0_transpose_item(F.w_lora_up, RANK_W, RWD, WL, 0, nullptr, scr, r, F.lane); continue; } r -= I_WL;
        p0_transpose_item(F.a_lora_up, RANK_A, RWD, AL, 0, nullptr, scr, r, F.lane);
    }
    const int gt = F.vcu * (NWAVES * 64) + F.tid, NGT = F.G * NWAVES * 64;
    for (int i = gt; i < (IN_PAD - IN_COLS) * D / 8; i += NGT) ((GAS v4u*)(WIN + (size_t)IN_COLS * D))[i] = (v4u){0u, 0u, 0u, 0u};
    for (int i = gt; i < RWD * RANK_G; i += NGT) { const int n = i / RANK_G, rho = i % RANK_G; GL[i] = (bf16)f2bf(F.g_lora_up[(size_t)rho * RWD + n]); }
    bf16* XN = (bf16*)(F.ws + WS_ABUF); bf16* PB = (bf16*)(F.ws + WS_PB);
    for (int m = gw; m < M; m += NGW) {
        rms_row_to_bf16(F, F.x + (size_t)m * D, F.norm_mix_g, XN + (size_t)m * D);
        const f32x4 pv = ((const GAS f32x4*)(F.p + (size_t)m * PLE))[F.lane];
        ((GAS unsigned long long*)(PB + (size_t)m * PLE))[F.lane] = (unsigned long long)pk2(pv.x, pv.y) | ((unsigned long long)pk2(pv.z, pv.w) << 32);
    }
}
DI void final_norm(Frame& F) {
    const int gw = F.vcu * NWAVES + F.wave, NGW = F.G * NWAVES;
    const float* ssq = (const float*)(F.ws + WS_SSQ3);
    const GAS f32x4* gr = (const GAS f32x4*)F.norm_final_g + F.lane;
    f32x4 gg[4];
#pragma unroll
    for (int j = 0; j < 4; ++j) gg[j] = gr[64 * j];
    for (int m = gw; m < M; m += NGW) {
        const f32x4 s4 = *(const GAS f32x4*)(ssq + (size_t)m * 4); const float rstd = rsqrtf(((s4[0] + s4[1]) + (s4[2] + s4[3])) * (1.f / D) + RMS_EPS);
        GAS f32x4* xr = (GAS f32x4*)(F.out + (size_t)m * D) + F.lane;
#pragma unroll
        for (int j = 0; j < 4; ++j) { f32x4 v = xr[64 * j]; v = v * rstd * gg[j]; xr[64 * j] = v; }
    }
}

#define MFMA16(a, b, c) __builtin_amdgcn_mfma_f32_16x16x32_bf16((a), (b), (c), 0, 0, 0)
typedef float f32x16 __attribute__((ext_vector_type(16)));
#define MFMA32(a, b, c) __builtin_amdgcn_mfma_f32_32x32x16_bf16((a), (b), (c), 0, 0, 0)
DI void load_shift8(const bf16* proj, size_t row, bool has_prev, int col, const float* shift_mu, float (&o)[8]) {
    const v4u c = *(const GAS v4u*)(proj + row * PROJ_LD + col);
    v4u p = *(const GAS v4u*)(proj + (row - (has_prev ? 1 : 0)) * PROJ_LD + col); if (!has_prev) p = (v4u){0u, 0u, 0u, 0u};
    const f32x4 m0 = *(const GAS f32x4*)(shift_mu + (col - CONV_COLS)), m1 = *(const GAS f32x4*)(shift_mu + (col - CONV_COLS) + 4);
    float cu[8], pr[8]; unpack8(c, cu); unpack8(p, pr);
    const float mu[8] = {m0[0], m0[1], m0[2], m0[3], m1[0], m1[1], m1[2], m1[3]};
#pragma unroll
    for (int j = 0; j < 8; ++j) o[j] = cu[j] + mu[j] * (pr[j] - cu[j]);
}
DI void ld8f(const float* g, float (&o)[8]) { const f32x4 a = *(const GAS f32x4*)g, b = *(const GAS f32x4*)(g + 4); o[0] = a[0]; o[1] = a[1]; o[2] = a[2]; o[3] = a[3]; o[4] = b[0]; o[5] = b[1]; o[6] = b[2]; o[7] = b[3]; }
DI void lds_ld8f(const LAS float* g, float (&o)[8]) { const f32x4 a = *(const LAS f32x4*)g, b = *(const LAS f32x4*)(g + 4); o[0] = a[0]; o[1] = a[1]; o[2] = a[2]; o[3] = a[3]; o[4] = b[0]; o[5] = b[1]; o[6] = b[2]; o[7] = b[3]; }
DI void lds_st8f(LAS float* g, const float (&v)[8]) { *(LAS f32x4*)g = (f32x4){v[0], v[1], v[2], v[3]}; *(LAS f32x4*)(g + 4) = (f32x4){v[4], v[5], v[6], v[7]}; }
template <int KS> DI void mm_ll(f32x4& acc, const LAS bf16* A, int lda, const LAS bf16* Bt, int ldb, int mt, int nt, int fr, int fq) {
#pragma unroll
    for (int s = 0; s < KS; ++s) { const bf16x8 a = *(const LAS bf16x8*)(A + (mt * 16 + fr) * lda + s * 32 + fq * 8); const bf16x8 b = *(const LAS bf16x8*)(Bt + (nt * 16 + fr) * ldb + s * 32 + fq * 8);
        acc = MFMA16(b, a, acc); }
}
template <int KS> DI void mm_lg(f32x4& acc, const LAS bf16* A, int lda, const bf16* Bt, int ldb, int mt, int nt, int fr, int fq) {
#pragma unroll
    for (int s = 0; s < KS; ++s) { const bf16x8 a = *(const LAS bf16x8*)(A + (mt * 16 + fr) * lda + s * 32 + fq * 8); const bf16x8 b = *(const GAS bf16x8*)(Bt + (size_t)(nt * 16 + fr) * ldb + s * 32 + fq * 8);
        acc = MFMA16(b, a, acc); }
}

DI void rw_prep1(Frame& F, const bf16* proj, int b, int h, int c, LAS bf16* XW, LAS bf16* XA, float (&r8)[8], float (&k8)[8], float (&v8)[8]) {
    const int t = F.tid >> 3, cg = F.tid & 7, tau = c * CH + t; const size_t row = (size_t)b * T + tau; const bool hp = tau > 0;
    load_shift8(proj, row, hp, C_R + h * HD + cg * 8, F.shift_mu, r8);
    load_shift8(proj, row, hp, C_K + h * HD + cg * 8, F.shift_mu, k8);
    load_shift8(proj, row, hp, C_V + h * HD + cg * 8, F.shift_mu, v8);
    float xw[8], xa[8];
    load_shift8(proj, row, hp, C_XW + cg * 8, F.shift_mu, xw);
    load_shift8(proj, row, hp, C_XA + cg * 8, F.shift_mu, xa);
#pragma unroll
    for (int j = 0; j < 8; ++j) xw[j] = tanhf(xw[j]);
    *(LAS v4u*)(XW + t * MLD + cg * 8) = pack8(xw);
    *(LAS v4u*)(XA + t * MLD + cg * 8) = pack8(xa);
}
DI void rw_lora(Frame& F, int h, const LAS bf16* XW, const LAS bf16* XA, LAS float* LW, LAS float* IC) {
    const int mt = F.wave >> 1, nt0 = (F.wave & 1) * 2, fr = F.lane & 15, fq = F.lane >> 4;
    const bf16* WL = (const bf16*)(F.ws + WS_WL) + (size_t)h * HD * RANK_W; const bf16* AL = (const bf16*)(F.ws + WS_AL) + (size_t)h * HD * RANK_A;
#pragma unroll
    for (int q = 0; q < 2; ++q) { const int nt = nt0 + q; const int n0 = nt * 16 + 4 * fq;
        f32x4 aw = (f32x4){0.f, 0.f, 0.f, 0.f}, aa = aw;
        mm_lg<2>(aw, XW, MLD, WL, RANK_W, mt, nt, fr, fq);
        mm_lg<2>(aa, XA, MLD, AL, RANK_A, mt, nt, fr, fq);
        const f32x4 w0v = *(const GAS f32x4*)(F.w0 + h * HD + n0), a0v = *(const GAS f32x4*)(F.a0 + h * HD + n0);
        f32x4 lw, ic;
#pragma unroll
        for (int i = 0; i < 4; ++i) { const float z = aw[i] + w0v[i]; const float xs = -z; const float sp = fmaxf(xs, 0.f) + log1pf(expf(-fabsf(xs))); lw[i] = -expf(-sp - 0.5f); ic[i] = sigmoidf_(aa[i] + a0v[i]); }
        *(LAS f32x4*)(LW + (mt * 16 + fr) * 64 + n0) = lw; *(LAS f32x4*)(IC + (mt * 16 + fr) * 64 + n0) = ic; }
}
constexpr int GLD = 168;
DI void rw_gate_prep(Frame& F, const bf16* proj, int b, int c, LAS bf16* XG) {
    const int t = F.tid >> 3, cg = F.tid & 7, tau = c * CH + t; const size_t row = (size_t)b * T + tau; const bool hp = tau > 0;
#pragma unroll
    for (int q = 0; q < 3; ++q) { const int g8 = cg + 8 * q; if (g8 < RANK_G / 8) { float xg[8]; load_shift8(proj, row, hp, C_XG + g8 * 8, F.shift_mu, xg);
#pragma unroll
        for (int j = 0; j < 8; ++j) xg[j] = sigmoidf_(xg[j]);
        *(LAS v4u*)(XG + t * GLD + g8 * 8) = pack8(xg); } }
}
DI void rw_gate_mm(Frame& F, int h, const LAS bf16* XG, LAS float* Gm) {
    const int mt = F.wave >> 1, nt0 = (F.wave & 1) * 2, fr = F.lane & 15, fq = F.lane >> 4;
    const bf16* GL = (const bf16*)(F.ws + WS_GL) + (size_t)h * HD * RANK_G;
#pragma unroll
    for (int q = 0; q < 2; ++q) { const int nt = nt0 + q; f32x4 ag = (f32x4){0.f, 0.f, 0.f, 0.f};
        mm_lg<5>(ag, XG, GLD, GL, RANK_G, mt, nt, fr, fq);
        *(LAS f32x4*)(Gm + (mt * 16 + fr) * 64 + nt * 16 + 4 * fq) = ag; }
}
DI void rw_out_epi(Frame& F, int b, int h, int c, const float (&y8)[8], const float (&v8)[8], float cb, const float (&g8)[8]) {
    const int t = F.tid >> 3, cg = F.tid & 7; const size_t row = (size_t)b * T + c * CH + t;
    float s = 0.f;
#pragma unroll
    for (int j = 0; j < 8; ++j) s += y8[j];
    const float mean = red8(s) * (1.f / 64.f); float q = 0.f;
#pragma unroll
    for (int j = 0; j < 8; ++j) { const float d = y8[j] - mean; q += d * d; }
    const float rstd = rsqrtf(red8(q) * (1.f / 64.f) + GN_EPS);
    float lg[8], lb[8], o[8]; ld8f(F.ln_x_g + h * HD + cg * 8, lg); ld8f(F.ln_x_b + h * HD + cg * 8, lb);
#pragma unroll
    for (int j = 0; j < 8; ++j) o[j] = ((y8[j] - mean) * rstd * lg[j] + lb[j] + cb * v8[j]) * g8[j];
    bf16* mix = (bf16*)(F.ws + WS_MIX);
    *(GAS v4u*)(mix + row * D + CONVD + h * HD + cg * 8) = pack8(o);
}
DI void conv_wave(Frame& F, int cw, int nw) {
    const bf16* proj = (const bf16*)(F.ws + WS_PROJ); bf16* mix = (bf16*)(F.ws + WS_MIX);
    const int ch = F.lane * 8;
    float w0[8], w1[8], w2[8]; ld8f(F.conv_w + ch, w0); ld8f(F.conv_w + CONVD + ch, w1); ld8f(F.conv_w + 2 * CONVD + ch, w2);
    for (int m = cw; m < M; m += nw) {
        const int tau = m % T; const bf16* pr = proj + (size_t)m * PROJ_LD;
        const int d1 = tau >= 1 ? 1 : 0, d2 = tau >= 2 ? 2 : 0;
        const v4u gbw = *(const GAS v4u*)(pr + ch), c2 = *(const GAS v4u*)(pr + CONVD + ch), h2 = *(const GAS v4u*)(pr + 2 * CONVD + ch);
        const v4u c1 = *(const GAS v4u*)(pr - d1 * PROJ_LD + CONVD + ch), h1 = *(const GAS v4u*)(pr - d1 * PROJ_LD + 2 * CONVD + ch);
        const v4u c0 = *(const GAS v4u*)(pr - d2 * PROJ_LD + CONVD + ch), h0 = *(const GAS v4u*)(pr - d2 * PROJ_LD + 2 * CONVD + ch);
        float gb[8], gc[8], hx[8], o[8], u[8];
        unpack8(gbw, gb);
        unpack8(c2, gc); unpack8(h2, hx);
#pragma unroll
        for (int j = 0; j < 8; ++j) o[j] = gc[j] * hx[j] * w2[j];
        unpack8(c1, gc); unpack8(h1, hx);
#pragma unroll
        for (int j = 0; j < 8; ++j) { u[j] = (tau >= 1) ? gc[j] * hx[j] : 0.f; o[j] += u[j] * w1[j]; }
        unpack8(c0, gc); unpack8(h0, hx);
#pragma unroll
        for (int j = 0; j < 8; ++j) { u[j] = (tau >= 2) ? gc[j] * hx[j] : 0.f; o[j] = gb[j] * (o[j] + u[j] * w0[j]); }
        *(GAS v4u*)(mix + (size_t)m * D + ch) = pack8(o);
    }
}
#ifndef MK_NAIVE
#define MK_NAIVE 0
#endif
#if MK_NAIVE
DI void rwkv_naive_chain(Frame& F, int chain) {
    const int b = chain / NH, h = chain % NH;
    const bf16* proj = (const bf16*)(F.ws + WS_PROJ);
    LAS float* F0 = (LAS float*)(F.lds);
    LAS float* F1 = F0 + 4096;
    LAS float* FR = F0 + 2 * 4096; LAS float* FK = F0 + 3 * 4096; LAS float* FV = F0 + 4 * 4096; LAS float* FA = F0 + 5 * 4096; LAS float* FB = F0 + 6 * 4096;
    LAS bf16* XW = (LAS bf16*)(F.lds + 7 * 16384); LAS bf16* XA = XW + 64 * MLD;
    LAS bf16* XG = (LAS bf16*)FA;
    LAS float* Gm = FR;
    const int t = F.tid >> 3, cg = F.tid & 7;
    float S[8];
#pragma unroll
    for (int j = 0; j < 8; ++j) S[j] = 0.f;
    float kkw[8], kaw[8], rkw[8]; ld8f(F.k_k + h * HD + cg * 8, kkw); ld8f(F.k_a + h * HD + cg * 8, kaw); ld8f(F.r_k + h * HD + cg * 8, rkw);
    for (int c = 0; c < NCH; ++c) {
        float r8[8], k8[8], v8[8];
        rw_prep1(F, proj, b, h, c, XW, XA, r8, k8, v8);
        LDS_WAIT(); __syncthreads();
        rw_lora(F, h, XW, XA, F0, F1);
        LDS_WAIT(); __syncthreads();
        float lw[8], ic[8]; lds_ld8f(F0 + t * 64 + cg * 8, lw); lds_ld8f(F1 + t * 64 + cg * 8, ic);
        float kk[8], ss = 0.f;
#pragma unroll
        for (int j = 0; j < 8; ++j) { kk[j] = k8[j] * kkw[j]; ss += kk[j] * kk[j]; }
        const float inv = 1.0f / fmaxf(sqrtf(red8(ss)), L2_EPS);
        float kh[8], a8[8], b8[8], w8[8], cbp = 0.f;
#pragma unroll
        for (int j = 0; j < 8; ++j) { const float kn = kk[j] * inv; kh[j] = k8[j] * (1.0f + (ic[j] - 1.0f) * kaw[j]); a8[j] = -kn; b8[j] = kn * ic[j]; w8[j] = expf(lw[j]); cbp += r8[j] * kh[j] * rkw[j]; }
        const float cb = red8(cbp);
        __syncthreads();
        lds_st8f(F0 + t * 64 + cg * 8, w8); lds_st8f(FR + t * 64 + cg * 8, r8); lds_st8f(FK + t * 64 + cg * 8, kh); lds_st8f(FV + t * 64 + cg * 8, v8); lds_st8f(FA + t * 64 + cg * 8, a8); lds_st8f(FB + t * 64 + cg * 8, b8);
        LDS_WAIT(); __syncthreads();
        for (int s = 0; s < CH; ++s) {
            float aa[8], bb[8], ww[8], kx[8], rr[8];
            lds_ld8f(FA + s * 64 + cg * 8, aa); lds_ld8f(FB + s * 64 + cg * 8, bb); lds_ld8f(F0 + s * 64 + cg * 8, ww); lds_ld8f(FK + s * 64 + cg * 8, kx); lds_ld8f(FR + s * 64 + cg * 8, rr);
            const float vi = FV[s * 64 + t];
            float sa = 0.f;
#pragma unroll
            for (int j = 0; j < 8; ++j) sa += S[j] * aa[j];
            sa = red8(sa);
            float y = 0.f;
#pragma unroll
            for (int j = 0; j < 8; ++j) { S[j] = S[j] * ww[j] + sa * bb[j] + vi * kx[j]; y += S[j] * rr[j]; }
            y = red8(y);
            if (cg == 0) F1[s * 64 + t] = y;
        }
        LDS_WAIT(); __syncthreads();
        rw_gate_prep(F, proj, b, c, XG);
        LDS_WAIT(); __syncthreads();
        rw_gate_mm(F, h, XG, Gm);
        LDS_WAIT(); __syncthreads();
        float y8[8], g8[8]; lds_ld8f(F1 + t * 64 + cg * 8, y8); lds_ld8f(Gm + t * 64 + cg * 8, g8);
        rw_out_epi(F, b, h, c, y8, v8, cb, g8);
        __syncthreads();
    }
}

#endif
DI LAS bf16* slotp(Frame& F, int i) { return (LAS bf16*)(F.lds + i * SLOT); }
DI void st_n(LAS bf16* Dst, int mt, int nt, int fr, int fq, const f32x4 v) { v2u w; w.x = pk2(v[0], v[1]); w.y = pk2(v[2], v[3]); *(LAS v2u*)(Dst + (mt * 16 + fr) * MLD + nt * 16 + 4 * fq) = w; }
DI void st_t(LAS bf16* Dst, int mt, int nt, int fr, int fq, const f32x4 v) {
#pragma unroll
    for (int i = 0; i < 4; ++i) Dst[(nt * 16 + 4 * fq + i) * MLD + mt * 16 + fr] = (bf16)f2bf(v[i]); }
DI f32x4 ld_tile(const LAS bf16* Src, int mt, int nt, int fr, int fq) { const v2u w = *(const LAS v2u*)(Src + (mt * 16 + fr) * MLD + nt * 16 + 4 * fq); return (f32x4){bflo(w.x), bfhi(w.x), bflo(w.y), bfhi(w.y)}; }
DI void st_g(bf16* Dst, int mt, int nt, int fr, int fq, const f32x4 v) { v2u w; w.x = pk2(v[0], v[1]); w.y = pk2(v[2], v[3]); *(GAS v2u*)(Dst + (mt * 16 + fr) * 64 + nt * 16 + 4 * fq) = w; }
DI f32x4 ld_g(const bf16* Src, int mt, int nt, int fr, int fq) { const v2u w = *(const GAS v2u*)(Src + (mt * 16 + fr) * 64 + nt * 16 + 4 * fq); return (f32x4){bflo(w.x), bfhi(w.x), bflo(w.y), bfhi(w.y)}; }
template <int KS> DI void mm_gg(f32x4& acc, const bf16* A, int lda, const bf16* Bt, int ldb, int mt, int nt, int fr, int fq) {
#pragma unroll
    for (int s = 0; s < KS; ++s) { const bf16x8 a = *(const GAS bf16x8*)(A + (size_t)(mt * 16 + fr) * lda + s * 32 + fq * 8); const bf16x8 b = *(const GAS bf16x8*)(Bt + (size_t)(nt * 16 + fr) * ldb + s * 32 + fq * 8);
        acc = MFMA16(b, a, acc); }
}
constexpr size_t CHUNK_ELEMS = 64 * 64, NCHUNKS = (size_t)BATCH * NH * NCH;
DI bf16* chunk_PT(Frame& F) { return (bf16*)F.out; }
DI bf16* chunk_Q(Frame& F) { return (bf16*)F.out + NCHUNKS * CHUNK_ELEMS; }
DI bf16* chunk_RW(Frame& F) { return (bf16*)F.out + 2 * NCHUNKS * CHUNK_ELEMS; }
DI bf16* chunk_YP(Frame& F) { return (bf16*)F.out + 3 * NCHUNKS * CHUNK_ELEMS; }
#define BAR() do { LDS_WAIT(); __syncthreads(); } while (0)

DI void rw_chunk_item(Frame& F, int b, int h, int c) {
    const bf16* proj = (const bf16*)(F.ws + WS_PROJ);
    const size_t ci = ((size_t)(b * NH + h) * NCH + c) * CHUNK_ELEMS;
    const int t = F.tid >> 3, cg = F.tid & 7;
    const int mt = F.wave >> 1, nt0 = (F.wave & 1) * 2, fr = F.lane & 15, fq = F.lane >> 4;
    LAS bf16* XW = slotp(F, 0); LAS bf16* XA = slotp(F, 1); LAS float* LW = (LAS float*)slotp(F, 2); LAS float* IC = (LAS float*)slotp(F, 4); LAS float* SEG = (LAS float*)slotp(F, 14);
    LAS float* GC = (LAS float*)(F.lds + LDSCTL_OFF + 512);
    LAS bf16* sAt = slotp(F, 6); LAS bf16* sAtT = slotp(F, 7); LAS bf16* sRt = slotp(F, 8); LAS bf16* sBt = slotp(F, 9); LAS bf16* sKt = slotp(F, 10); LAS bf16* sBhT = slotp(F, 11); LAS bf16* sKhT = slotp(F, 12); LAS bf16* sVt = slotp(F, 13);
    float r8[8], k8[8], v8[8];
    rw_prep1(F, proj, b, h, c, XW, XA, r8, k8, v8);
    BAR();
    rw_lora(F, h, XW, XA, LW, IC);
    BAR();
    {
        const int seg = F.wave, kc = F.lane; float pfx[8]; float run = 0.f;
#pragma unroll
        for (int j = 0; j < 8; ++j) { run += LW[(seg * 8 + j) * 64 + kc]; pfx[j] = run; }
        SEG[seg * 64 + kc] = run;
        BAR();
        float off = 0.f;
#pragma unroll
        for (int s = 0; s < 8; ++s) { const float sv = SEG[s * 64 + kc]; off += (s < seg) ? sv : 0.f; }
#pragma unroll
        for (int j = 0; j < 8; ++j) LW[(seg * 8 + j) * 64 + kc] = pfx[j] + off;
        BAR();
    }
    {
        float Lt[8], Lm[8], LC[8], ic[8];
        lds_ld8f(LW + t * 64 + cg * 8, Lt); lds_ld8f(LW + 63 * 64 + cg * 8, LC); lds_ld8f(IC + t * 64 + cg * 8, ic);
        if (t > 0) lds_ld8f(LW + (t - 1) * 64 + cg * 8, Lm); else {
#pragma unroll
            for (int j = 0; j < 8; ++j) Lm[j] = 0.f; }
        float kkw[8], kaw[8], rkw[8]; ld8f(F.k_k + h * HD + cg * 8, kkw); ld8f(F.k_a + h * HD + cg * 8, kaw); ld8f(F.r_k + h * HD + cg * 8, rkw);
        float kk[8], ss = 0.f;
#pragma unroll
        for (int j = 0; j < 8; ++j) { kk[j] = k8[j] * kkw[j]; ss += kk[j] * kk[j]; }
        const float inv = 1.0f / fmaxf(sqrtf(red8(ss)), L2_EPS);
        float at[8], rt[8], bt[8], kt[8], bh[8], khh[8], cbp = 0.f;
#pragma unroll
        for (int j = 0; j < 8; ++j) { const float kn = kk[j] * inv; const float kh = k8[j] * (1.0f + (ic[j] - 1.0f) * kaw[j]); const float bb = kn * ic[j];
            const float em = expf(Lm[j]), et = expf(Lt[j]), en = expf(-Lt[j]), ec = expf(LC[j] - Lt[j]);
            at[j] = -kn * em; rt[j] = r8[j] * et; bt[j] = bb * en; kt[j] = kh * en; bh[j] = bb * ec; khh[j] = kh * ec; cbp += r8[j] * kh * rkw[j]; }
        const float cb = red8(cbp);
        if (cg == 0) ((float*)(F.ws + WS_CB))[((size_t)b * T + c * CH + t) * NH + h] = cb;
        if (t == 63) {
#pragma unroll
            for (int j = 0; j < 8; ++j) GC[cg * 8 + j] = expf(LC[j]); }
        *(LAS v4u*)(sAt + t * MLD + cg * 8) = pack8(at); *(LAS v4u*)(sRt + t * MLD + cg * 8) = pack8(rt); *(LAS v4u*)(sBt + t * MLD + cg * 8) = pack8(bt); *(LAS v4u*)(sKt + t * MLD + cg * 8) = pack8(kt);
#pragma unroll
        for (int j = 0; j < 8; ++j) { const int kc = cg * 8 + j; sAtT[kc * MLD + t] = (bf16)f2bf(at[j]); sBhT[kc * MLD + t] = (bf16)f2bf(bh[j]); sKhT[kc * MLD + t] = (bf16)f2bf(khh[j]); sVt[kc * MLD + t] = (bf16)f2bf(v8[j]); }
    }
    BAR();
    LAS bf16* sN = slotp(F, 0); LAS bf16* sNT = slotp(F, 1); LAS bf16* sT0 = slotp(F, 2); LAS bf16* sAak = slotp(F, 3); LAS bf16* sArb = slotp(F, 4); LAS bf16* sArk = slotp(F, 5);
#pragma unroll
    for (int q = 0; q < 2; ++q) { const int nt = nt0 + q; const f32x4 z = (f32x4){0.f, 0.f, 0.f, 0.f};
        f32x4 ab = z, ak = z, rb = z, rk = z;
        if (nt <= mt) { mm_ll<2>(ab, sAt, MLD, sBt, MLD, mt, nt, fr, fq); mm_ll<2>(ak, sAt, MLD, sKt, MLD, mt, nt, fr, fq); mm_ll<2>(rb, sRt, MLD, sBt, MLD, mt, nt, fr, fq); mm_ll<2>(rk, sRt, MLD, sKt, MLD, mt, nt, fr, fq); }
        const int m = mt * 16 + fr; f32x4 t0;
#pragma unroll
        for (int i = 0; i < 4; ++i) { const int n = nt * 16 + 4 * fq + i; if (!(n < m)) { ab[i] = 0.f; ak[i] = 0.f; } if (!(n <= m)) { rb[i] = 0.f; rk[i] = 0.f; } t0[i] = ab[i] + ((n == m) ? 1.0f : 0.f); }
        st_n(sN, mt, nt, fr, fq, ab); st_t(sNT, mt, nt, fr, fq, ab); st_n(sT0, mt, nt, fr, fq, t0); st_n(sAak, mt, nt, fr, fq, ak); st_n(sArb, mt, nt, fr, fq, rb); st_n(sArk, mt, nt, fr, fq, rk); }
    BAR();
    LAS bf16* sM1T = slotp(F, 9);
#pragma unroll
    for (int q = 0; q < 2; ++q) { const int nt = nt0 + q; f32x4 n2 = (f32x4){0.f, 0.f, 0.f, 0.f}, m1 = n2;
        mm_ll<2>(n2, sN, MLD, sNT, MLD, mt, nt, fr, fq); mm_ll<2>(m1, sAak, MLD, sVt, MLD, mt, nt, fr, fq);
        st_n(slotp(F, 15), mt, nt, fr, fq, n2); st_t(slotp(F, 6), mt, nt, fr, fq, n2); st_t(sM1T, mt, nt, fr, fq, m1); }
    BAR();
    for (int it = 1; it <= 5; ++it) {
        const bool odd = it & 1;
        const LAS bf16* cT = slotp(F, odd ? 2 : 14); const LAS bf16* cNp = slotp(F, odd ? 15 : 0); const LAS bf16* cNpT = slotp(F, odd ? 6 : 1);
        LAS bf16* dT = slotp(F, odd ? 14 : 2); LAS bf16* dNp = slotp(F, odd ? 0 : 15); LAS bf16* dNpT = slotp(F, odd ? 1 : 6);
#pragma unroll
        for (int q = 0; q < 2; ++q) { const int nt = nt0 + q; f32x4 tn = ld_tile(cT, mt, nt, fr, fq);
            mm_ll<2>(tn, cT, MLD, cNpT, MLD, mt, nt, fr, fq); st_n(dT, mt, nt, fr, fq, tn);
            if (it < 5) { f32x4 n2 = (f32x4){0.f, 0.f, 0.f, 0.f}; mm_ll<2>(n2, cNp, MLD, cNpT, MLD, mt, nt, fr, fq); st_n(dNp, mt, nt, fr, fq, n2); st_t(dNpT, mt, nt, fr, fq, n2); } }
        BAR();
    }
    LAS bf16* sTm = slotp(F, 14); LAS bf16* sWT = slotp(F, 0); LAS bf16* sUT = slotp(F, 1);
#pragma unroll
    for (int q = 0; q < 2; ++q) { const int nt = nt0 + q; f32x4 w = (f32x4){0.f, 0.f, 0.f, 0.f}, u = w;
        mm_ll<2>(w, sTm, MLD, sAtT, MLD, mt, nt, fr, fq); mm_ll<2>(u, sTm, MLD, sM1T, MLD, mt, nt, fr, fq);
        st_t(sWT, mt, nt, fr, fq, w); st_t(sUT, mt, nt, fr, fq, u); }
    BAR();
    bf16* gPT = chunk_PT(F) + ci; bf16* gQ = chunk_Q(F) + ci; bf16* gRW = chunk_RW(F) + ci; bf16* gYP = chunk_YP(F) + ci;
#pragma unroll
    for (int q = 0; q < 2; ++q) { const int nt = nt0 + q; const f32x4 z = (f32x4){0.f, 0.f, 0.f, 0.f};
        f32x4 pt = z, qq = z, rw = ld_tile(sRt, mt, nt, fr, fq), yp = z;
        mm_ll<2>(pt, sBhT, MLD, sWT, MLD, mt, nt, fr, fq);
        const int m = mt * 16 + fr;
#pragma unroll
        for (int i = 0; i < 4; ++i) { const int n = nt * 16 + 4 * fq + i; if (n == m) pt[i] += GC[m]; }
        mm_ll<2>(qq, sUT, MLD, sBhT, MLD, mt, nt, fr, fq); mm_ll<2>(qq, sVt, MLD, sKhT, MLD, mt, nt, fr, fq);
        mm_ll<2>(rw, sArb, MLD, sWT, MLD, mt, nt, fr, fq);
        mm_ll<2>(yp, sArb, MLD, sUT, MLD, mt, nt, fr, fq); mm_ll<2>(yp, sArk, MLD, sVt, MLD, mt, nt, fr, fq);
        st_g(gPT, mt, nt, fr, fq, pt); st_g(gQ, mt, nt, fr, fq, qq); st_g(gRW, mt, nt, fr, fq, rw); st_g(gYP, mt, nt, fr, fq, yp); }
    BAR();
}
DI void rw_scan_chain(Frame& F, int chain) {
    const int mt = F.wave >> 1, nt0 = (F.wave & 1) * 2, fr = F.lane & 15, fq = F.lane >> 4;
    bf16* SB = (bf16*)(F.ws + WS_SB) + (size_t)chain * NCH * CHUNK_ELEMS;
    const bf16* gPT = chunk_PT(F) + (size_t)chain * NCH * CHUNK_ELEMS; const bf16* gQ = chunk_Q(F) + (size_t)chain * NCH * CHUNK_ELEMS;
    LAS bf16* S0 = slotp(F, 0); LAS bf16* S1 = slotp(F, 1);
    const f32x4 z = (f32x4){0.f, 0.f, 0.f, 0.f};
#pragma unroll
    for (int q = 0; q < 2; ++q) { st_n(S0, mt, nt0 + q, fr, fq, z); st_g(SB, mt, nt0 + q, fr, fq, z); }
    BAR();
    bf16x8 pb[2][2]; v2u qv[2];
#pragma unroll
    for (int q = 0; q < 2; ++q) { const int nt = nt0 + q;
#pragma unroll
        for (int s = 0; s < 2; ++s) pb[q][s] = *(const GAS bf16x8*)(gPT + (size_t)(nt * 16 + fr) * 64 + s * 32 + fq * 8);
        qv[q] = *(const GAS v2u*)(gQ + (mt * 16 + fr) * 64 + nt * 16 + 4 * fq); }
    for (int c = 0; c < NCH - 1; ++c) {
        const LAS bf16* cur = (c & 1) ? S1 : S0; LAS bf16* nxt = (c & 1) ? S0 : S1;
        bf16x8 pn[2][2]; v2u qn[2];
        const int cn = (c + 1 < NCH - 1) ? c + 1 : c;
#pragma unroll
        for (int q = 0; q < 2; ++q) { const int nt = nt0 + q;
#pragma unroll
            for (int s = 0; s < 2; ++s) pn[q][s] = *(const GAS bf16x8*)(gPT + (size_t)cn * CHUNK_ELEMS + (size_t)(nt * 16 + fr) * 64 + s * 32 + fq * 8);
            qn[q] = *(const GAS v2u*)(gQ + (size_t)cn * CHUNK_ELEMS + (mt * 16 + fr) * 64 + nt * 16 + 4 * fq); }
        bf16x8 a[2];
#pragma unroll
        for (int s = 0; s < 2; ++s) a[s] = *(const LAS bf16x8*)(cur + (mt * 16 + fr) * MLD + s * 32 + fq * 8);
#pragma unroll
        for (int q = 0; q < 2; ++q) { const int nt = nt0 + q; f32x4 acc = (f32x4){bflo(qv[q].x), bfhi(qv[q].x), bflo(qv[q].y), bfhi(qv[q].y)};
#pragma unroll
            for (int s = 0; s < 2; ++s) acc = MFMA16(pb[q][s], a[s], acc);
            st_n(nxt, mt, nt, fr, fq, acc); st_g(SB + (size_t)(c + 1) * CHUNK_ELEMS, mt, nt, fr, fq, acc); }
        BAR();
#pragma unroll
        for (int q = 0; q < 2; ++q) { qv[q] = qn[q];
#pragma unroll
            for (int s = 0; s < 2; ++s) pb[q][s] = pn[q][s]; }
    }
}
DI void rw_out_item(Frame& F, int b, int h, int c) {
    const bf16* proj = (const bf16*)(F.ws + WS_PROJ);
    const size_t ci = ((size_t)(b * NH + h) * NCH + c) * CHUNK_ELEMS;
    const int t = F.tid >> 3, cg = F.tid & 7;
    const int mt = F.wave >> 1, nt0 = (F.wave & 1) * 2, fr = F.lane & 15, fq = F.lane >> 4;
    LAS bf16* XG = slotp(F, 0); LAS float* Yf = (LAS float*)slotp(F, 3); LAS float* Gf = (LAS float*)slotp(F, 5);
    rw_gate_prep(F, proj, b, c, XG);
    const bf16* gRW = chunk_RW(F) + ci; const bf16* gYP = chunk_YP(F) + ci; const bf16* gS = (const bf16*)(F.ws + WS_SB) + ci;
#pragma unroll
    for (int q = 0; q < 2; ++q) { const int nt = nt0 + q; f32x4 y = ld_g(gYP, mt, nt, fr, fq);
        mm_gg<2>(y, gRW, 64, gS, 64, mt, nt, fr, fq);
        *(LAS f32x4*)(Yf + (mt * 16 + fr) * 64 + nt * 16 + 4 * fq) = y; }
    BAR();
    rw_gate_mm(F, h, XG, Gf);
    BAR();
    float y8[8], g8[8], v8[8]; lds_ld8f(Yf + t * 64 + cg * 8, y8); lds_ld8f(Gf + t * 64 + cg * 8, g8);
    const int tau = c * CH + t; const size_t row = (size_t)b * T + tau;
    load_shift8(proj, row, tau > 0, C_V + h * HD + cg * 8, F.shift_mu, v8);
    const float cb = ((const float*)(F.ws + WS_CB))[row * NH + h];
    rw_out_epi(F, b, h, c, y8, v8, cb, g8);
    BAR();
}


typedef short s16x4 __attribute__((ext_vector_type(4)));
DI bf16x8 fragN(const LAS bf16* Z, int row0, int k0, int fr, int fq) { return *(const LAS bf16x8*)(Z + (row0 + fr) * MLD + k0 + fq * 8); }
DI bf16x8 fragT(const LAS bf16* Z, int row0, int k0, int fr, int fq) {
    const LAS bf16* a = Z + (k0 + 8 * fq + (fr >> 2)) * MLD + row0 + 4 * (fr & 3);
    const s16x4 lo = __builtin_amdgcn_ds_read_tr16_b64_v4i16((LAS s16x4*)a);
    const s16x4 hi = __builtin_amdgcn_ds_read_tr16_b64_v4i16((LAS s16x4*)(a + 4 * MLD));
    return __builtin_shufflevector(lo, hi, 0, 1, 2, 3, 4, 5, 6, 7);
}
template <bool TA, bool TB> DI void mm2(f32x4& acc, const LAS bf16* ZA, const LAS bf16* ZB, int mt, int nt, int fr, int fq) {
#pragma unroll
    for (int s = 0; s < 2; ++s) { const bf16x8 a = TA ? fragT(ZA, mt * 16, s * 32, fr, fq) : fragN(ZA, mt * 16, s * 32, fr, fq); const bf16x8 b = TB ? fragT(ZB, nt * 16, s * 32, fr, fq) : fragN(ZB, nt * 16, s * 32, fr, fq);
        acc = MFMA16(b, a, acc); }
}
DI float fexp(float x) { return __expf(x); }
DI float frcp(float x) { return __builtin_amdgcn_rcpf(x); }
DI float fsigmoid(float x) { return frcp(1.0f + __expf(-x)); }
DI float ftanh(float x) { return 1.0f - 2.0f * frcp(1.0f + __expf(2.0f * x)); }
constexpr int PAR_OFF = LDSCTL_OFF + 1024;
struct RawRKV { v4u rc, rp, kc, kp, vc, vp; };
struct LoraB { bf16x8 w[2][2], a[2][2]; };
DI void rkv_issue(const bf16* proj, int b, int h, int c, int t, int cg, RawRKV& R) {
    const int tau = c * CH + t; const size_t row = (size_t)b * T + tau, prow = row - (tau > 0 ? 1 : 0); const int col = h * HD + cg * 8;
    R.rc = *(const GAS v4u*)(proj + row * PROJ_LD + C_R + col); R.rp = *(const GAS v4u*)(proj + prow * PROJ_LD + C_R + col);
    R.kc = *(const GAS v4u*)(proj + row * PROJ_LD + C_K + col); R.kp = *(const GAS v4u*)(proj + prow * PROJ_LD + C_K + col);
    R.vc = *(const GAS v4u*)(proj + row * PROJ_LD + C_V + col); R.vp = *(const GAS v4u*)(proj + prow * PROJ_LD + C_V + col);
}
DI void lora_issue(Frame& F, int h, int nt0, int fr, int fq, LoraB& L) {
    const bf16* WL = (const bf16*)(F.ws + WS_WL) + (size_t)h * HD * RANK_W; const bf16* AL = (const bf16*)(F.ws + WS_AL) + (size_t)h * HD * RANK_A;
#pragma unroll
    for (int q = 0; q < 2; ++q)
#pragma unroll
        for (int s = 0; s < 2; ++s) { L.w[q][s] = *(const GAS bf16x8*)(WL + (size_t)((nt0 + q) * 16 + fr) * RANK_W + s * 32 + fq * 8); L.a[q][s] = *(const GAS bf16x8*)(AL + (size_t)((nt0 + q) * 16 + fr) * RANK_A + s * 32 + fq * 8); }
}
DI void shift8(const v4u c, const v4u p, bool hp, const LAS float* mu, float (&o)[8]) {
    float cu[8], pr[8], m[8]; unpack8(c, cu); unpack8(p, pr); lds_ld8f(mu, m);
#pragma unroll
    for (int j = 0; j < 8; ++j) { const float pv = hp ? pr[j] : 0.f; o[j] = cu[j] + m[j] * (pv - cu[j]); }
}
DI void rw_chunk_wg(Frame& F, int b, int c) {
    const bf16* proj = (const bf16*)(F.ws + WS_PROJ);
    const int t = F.tid >> 3, cg = F.tid & 7;
    const int mt = F.wave >> 1, nt0 = (F.wave & 1) * 2, fr = F.lane & 15, fq = F.lane >> 4;
    const bool hp = (c * CH + t) > 0;
    LAS bf16* XW = slotp(F, 0); LAS bf16* XA = slotp(F, 1);
    LAS bf16* sAt = slotp(F, 2); LAS bf16* sRt = slotp(F, 3); LAS bf16* sBt = slotp(F, 4); LAS bf16* sKt = slotp(F, 5); LAS bf16* sBh = slotp(F, 6); LAS bf16* sKh = slotp(F, 7); LAS bf16* sV = slotp(F, 8);
    LAS float* LW = (LAS float*)slotp(F, 9); LAS float* IC = LW + 4096; LAS float* SEG = (LAS float*)slotp(F, 15);
    LAS bf16* sN = slotp(F, 9); LAS bf16* sAak = slotp(F, 10); LAS bf16* sArb = slotp(F, 11); LAS bf16* sArk = slotp(F, 12); LAS bf16* sTa = slotp(F, 13); LAS bf16* sTb = slotp(F, 14);
    LAS bf16* sNpb = slotp(F, 4); LAS bf16* sM1 = slotp(F, 5); LAS bf16* sW = slotp(F, 9); LAS bf16* sU = slotp(F, 10);
    LAS float* GC = (LAS float*)(F.lds + LDSCTL_OFF + 512);
    LAS float* PAR = (LAS float*)(F.lds + PAR_OFF);
    PAR[F.tid] = F.k_k[F.tid]; PAR[512 + F.tid] = F.k_a[F.tid]; PAR[1024 + F.tid] = F.r_k[F.tid];
    PAR[1536 + F.tid] = F.shift_mu[F.tid]; PAR[2048 + F.tid] = F.shift_mu[512 + F.tid]; PAR[2560 + F.tid] = F.shift_mu[1024 + F.tid];
    {   float xw[8], xa[8]; const size_t row = (size_t)b * T + c * CH + t;
        load_shift8(proj, row, hp, C_XW + cg * 8, F.shift_mu, xw); load_shift8(proj, row, hp, C_XA + cg * 8, F.shift_mu, xa);
#pragma unroll
        for (int j = 0; j < 8; ++j) xw[j] = ftanh(xw[j]);
        *(LAS v4u*)(XW + t * MLD + cg * 8) = pack8(xw); *(LAS v4u*)(XA + t * MLD + cg * 8) = pack8(xa); }
    RawRKV cur; rkv_issue(proj, b, 0, c, t, cg, cur);
    LoraB lb; lora_issue(F, 0, nt0, fr, fq, lb);
    BAR();
#pragma unroll 1
    for (int h = 0; h < NH; ++h) {
        const size_t ci = ((size_t)(b * NH + h) * NCH + c) * CHUNK_ELEMS;
#pragma unroll
        for (int q = 0; q < 2; ++q) { const int nt = nt0 + q, n0 = nt * 16 + 4 * fq; f32x4 aw = (f32x4){0.f, 0.f, 0.f, 0.f}, aa = aw;
#pragma unroll
            for (int s = 0; s < 2; ++s) { const bf16x8 xw = fragN(XW, mt * 16, s * 32, fr, fq), xa = fragN(XA, mt * 16, s * 32, fr, fq); aw = MFMA16(lb.w[q][s], xw, aw); aa = MFMA16(lb.a[q][s], xa, aa); }
            const f32x4 w0v = *(const GAS f32x4*)(F.w0 + h * HD + n0), a0v = *(const GAS f32x4*)(F.a0 + h * HD + n0);
            f32x4 lw, ic;
#pragma unroll
            for (int i = 0; i < 4; ++i) { const float xs = -(aw[i] + w0v[i]); const float sp = fmaxf(xs, 0.f) + __logf(1.0f + fexp(-fabsf(xs))); lw[i] = -fexp(-sp - 0.5f); ic[i] = fsigmoid(aa[i] + a0v[i]); }
            *(LAS f32x4*)(LW + (mt * 16 + fr) * 64 + n0) = lw; *(LAS f32x4*)(IC + (mt * 16 + fr) * 64 + n0) = ic; }
        const int hn = (h + 1 < NH) ? h + 1 : h;
        BAR();
        {
            const int seg = F.wave, kc = F.lane; float pfx[8]; float run = 0.f;
#pragma unroll
            for (int j = 0; j < 8; ++j) { run += LW[(seg * 8 + j) * 64 + kc]; pfx[j] = run; }
            SEG[seg * 64 + kc] = run;
            BAR();
            float off = 0.f;
#pragma unroll
            for (int s = 0; s < 8; ++s) { const float sv = SEG[s * 64 + kc]; off += (s < seg) ? sv : 0.f; }
#pragma unroll
            for (int j = 0; j < 8; ++j) LW[(seg * 8 + j) * 64 + kc] = pfx[j] + off;
            BAR();
        }
        {
            float r8[8], k8[8], v8[8];
            shift8(cur.rc, cur.rp, hp, PAR + 1536 + h * HD + cg * 8, r8); shift8(cur.kc, cur.kp, hp, PAR + 2048 + h * HD + cg * 8, k8); shift8(cur.vc, cur.vp, hp, PAR + 2560 + h * HD + cg * 8, v8);
            float Lt[8], Lm[8], LC[8], ic[8];
            lds_ld8f(LW + t * 64 + cg * 8, Lt); lds_ld8f(LW + 63 * 64 + cg * 8, LC); lds_ld8f(IC + t * 64 + cg * 8, ic);
            lds_ld8f(LW + (t > 0 ? t - 1 : 0) * 64 + cg * 8, Lm);
            if (t == 0) {
#pragma unroll
                for (int j = 0; j < 8; ++j) Lm[j] = 0.f; }
            float kkw[8], kaw[8], rkw[8]; lds_ld8f(PAR + h * HD + cg * 8, kkw); lds_ld8f(PAR + 512 + h * HD + cg * 8, kaw); lds_ld8f(PAR + 1024 + h * HD + cg * 8, rkw);
            float kk[8], ss = 0.f;
#pragma unroll
            for (int j = 0; j < 8; ++j) { kk[j] = k8[j] * kkw[j]; ss += kk[j] * kk[j]; }
            const float inv = rsqrtf(fmaxf(red8(ss), 1e-24f));
            float at[8], rt[8], bt[8], kt[8], bh[8], khh[8], cbp = 0.f;
#pragma unroll
            for (int j = 0; j < 8; ++j) { const float kn = kk[j] * inv; const float kh = k8[j] * (1.0f + (ic[j] - 1.0f) * kaw[j]); const float bb = kn * ic[j];
                const float em = fexp(Lm[j]), et = fexp(Lt[j]), en = fexp(-Lt[j]), ec = fexp(LC[j] - Lt[j]);
                at[j] = -kn * em; rt[j] = r8[j] * et; bt[j] = bb * en; kt[j] = kh * en; bh[j] = bb * ec; khh[j] = kh * ec; cbp += r8[j] * kh * rkw[j]; }
            const float cb = red8(cbp);
            if (cg == 0) ((float*)(F.ws + WS_CB))[((size_t)b * T + c * CH + t) * NH + h] = cb;
            if (t == 63) {
#pragma unroll
                for (int j = 0; j < 8; ++j) GC[cg * 8 + j] = fexp(LC[j]); }
            *(LAS v4u*)(sAt + t * MLD + cg * 8) = pack8(at); *(LAS v4u*)(sRt + t * MLD + cg * 8) = pack8(rt); *(LAS v4u*)(sBt + t * MLD + cg * 8) = pack8(bt); *(LAS v4u*)(sKt + t * MLD + cg * 8) = pack8(kt);
            *(LAS v4u*)(sBh + t * MLD + cg * 8) = pack8(bh); *(LAS v4u*)(sKh + t * MLD + cg * 8) = pack8(khh); *(LAS v4u*)(sV + t * MLD + cg * 8) = pack8(v8);
        }
        rkv_issue(proj, b, hn, c, t, cg, cur);
        BAR();
#pragma unroll
        for (int q = 0; q < 2; ++q) { const int nt = nt0 + q; const f32x4 z = (f32x4){0.f, 0.f, 0.f, 0.f};
            f32x4 ab = z, ak = z, rb = z, rk = z;
            if (nt <= mt) { mm2<false, false>(ab, sAt, sBt, mt, nt, fr, fq); mm2<false, false>(ak, sAt, sKt, mt, nt, fr, fq); mm2<false, false>(rb, sRt, sBt, mt, nt, fr, fq); mm2<false, false>(rk, sRt, sKt, mt, nt, fr, fq); }
            const int m = mt * 16 + fr; f32x4 t0;
#pragma unroll
            for (int i = 0; i < 4; ++i) { const int n = nt * 16 + 4 * fq + i; if (!(n < m)) { ab[i] = 0.f; ak[i] = 0.f; } if (!(n <= m)) { rb[i] = 0.f; rk[i] = 0.f; } t0[i] = ab[i] + ((n == m) ? 1.0f : 0.f); }
            st_n(sN, mt, nt, fr, fq, ab); st_n(sTa, mt, nt, fr, fq, t0); st_n(sAak, mt, nt, fr, fq, ak); st_n(sArb, mt, nt, fr, fq, rb); st_n(sArk, mt, nt, fr, fq, rk); }
        BAR();
#pragma unroll
        for (int q = 0; q < 2; ++q) { const int nt = nt0 + q; f32x4 n2 = (f32x4){0.f, 0.f, 0.f, 0.f}, m1 = n2;
            mm2<false, true>(n2, sN, sN, mt, nt, fr, fq); mm2<false, true>(m1, sAak, sV, mt, nt, fr, fq);
            st_n(sNpb, mt, nt, fr, fq, n2); st_n(sM1, mt, nt, fr, fq, m1); }
        BAR();
#pragma unroll 1
        for (int it = 1; it <= 5 + MK_XIT; ++it) {
            const bool odd = it & 1;
            const LAS bf16* cT = odd ? sTa : sTb; const LAS bf16* cNp = odd ? sNpb : sN; LAS bf16* dT = odd ? sTb : sTa; LAS bf16* dNp = odd ? sN : sNpb;
#pragma unroll
            for (int q = 0; q < 2; ++q) { const int nt = nt0 + q; f32x4 tn = ld_tile(cT, mt, nt, fr, fq);
                mm2<false, true>(tn, cT, cNp, mt, nt, fr, fq); st_n(dT, mt, nt, fr, fq, tn);
                if (it < 5 + MK_XIT) { f32x4 n2 = (f32x4){0.f, 0.f, 0.f, 0.f}; mm2<false, true>(n2, cNp, cNp, mt, nt, fr, fq); st_n(dNp, mt, nt, fr, fq, n2); } }
            BAR();
        }
        lora_issue(F, hn, nt0, fr, fq, lb);
#pragma unroll
        for (int q = 0; q < 2; ++q) { const int nt = nt0 + q; f32x4 w = (f32x4){0.f, 0.f, 0.f, 0.f}, u = w;
            mm2<false, true>(w, sTb, sAt, mt, nt, fr, fq); mm2<false, true>(u, sTb, sM1, mt, nt, fr, fq);
            st_n(sW, mt, nt, fr, fq, w); st_n(sU, mt, nt, fr, fq, u); }
        BAR();
        bf16* gPT = chunk_PT(F) + ci; bf16* gQ = chunk_Q(F) + ci; bf16* gRW = chunk_RW(F) + ci; bf16* gYP = chunk_YP(F) + ci;
#pragma unroll 1
        for (int xr = 0; xr < 1 + MK_XM5; ++xr)
#pragma unroll
        for (int q = 0; q < 2; ++q) { const int nt = nt0 + q; const f32x4 z = (f32x4){0.f, 0.f, 0.f, 0.f};
            f32x4 pt = z, qq = z, rw = ld_tile(sRt, mt, nt, fr, fq), yp = z;
            mm2<true, true>(pt, sBh, sW, mt, nt, fr, fq);
            const int m = mt * 16 + fr;
#pragma unroll
            for (int i = 0; i < 4; ++i) { const int n = nt * 16 + 4 * fq + i; if (n == m) pt[i] += GC[m]; }
            mm2<true, true>(qq, sU, sBh, mt, nt, fr, fq); mm2<true, true>(qq, sV, sKh, mt, nt, fr, fq);
            mm2<false, true>(rw, sArb, sW, mt, nt, fr, fq);
            mm2<false, true>(yp, sArb, sU, mt, nt, fr, fq); mm2<false, true>(yp, sArk, sV, mt, nt, fr, fq);
            st_g(gPT, mt, nt, fr, fq, pt); st_g(gQ, mt, nt, fr, fq, qq); st_g(gRW, mt, nt, fr, fq, rw); st_g(gYP, mt, nt, fr, fq, yp); }
        BAR();
    }
}

DI bf16x8 q32N(const LAS bf16* Z, int row0, int s, int lane) { return *(const LAS bf16x8*)(Z + (row0 + (lane & 31)) * MLD + s * 16 + (lane >> 5) * 8); }
DI bf16x8 q32T(const LAS bf16* Z, int row0, int s, int lane) {
    const int i = lane & 15, g = lane >> 4;
    const LAS bf16* a = Z + (s * 16 + (g >> 1) * 8 + (i >> 2)) * MLD + row0 + (g & 1) * 16 + 4 * (i & 3);
    const s16x4 lo = __builtin_amdgcn_ds_read_tr16_b64_v4i16((LAS s16x4*)a);
    const s16x4 hi = __builtin_amdgcn_ds_read_tr16_b64_v4i16((LAS s16x4*)(a + 4 * MLD));
    return __builtin_shufflevector(lo, hi, 0, 1, 2, 3, 4, 5, 6, 7);
}
template <bool TA, bool TB> DI void mm32(f32x16& acc, const LAS bf16* ZA, const LAS bf16* ZB, int m0, int n0, int lane) {
#pragma unroll
    for (int s = 0; s < 4; ++s) { const bf16x8 a = TA ? q32T(ZA, m0, s, lane) : q32N(ZA, m0, s, lane); const bf16x8 b = TB ? q32T(ZB, n0, s, lane) : q32N(ZB, n0, s, lane);
        acc = MFMA32(b, a, acc); }
}
DI void st32(LAS bf16* Dst, int m0, int n0, int lane, const f32x16& v) {
    LAS bf16* p = Dst + (m0 + (lane & 31)) * MLD + n0 + 4 * (lane >> 5);
#pragma unroll
    for (int g = 0; g < 4; ++g) { v2u w; w.x = pk2(v[4 * g], v[4 * g + 1]); w.y = pk2(v[4 * g + 2], v[4 * g + 3]); *(LAS v2u*)(p + 8 * g) = w; }
}
DI void ld32(const LAS bf16* Src, int m0, int n0, int lane, f32x16& v) {
    const LAS bf16* p = Src + (m0 + (lane & 31)) * MLD + n0 + 4 * (lane >> 5);
#pragma unroll
    for (int g = 0; g < 4; ++g) { const v2u w = *(const LAS v2u*)(p + 8 * g); v[4 * g] = bflo(w.x); v[4 * g + 1] = bfhi(w.x); v[4 * g + 2] = bflo(w.y); v[4 * g + 3] = bfhi(w.y); }
}
DI void stg32(bf16* Dst, int m0, int n0, int lane, const f32x16& v) {
    bf16* p = Dst + (m0 + (lane & 31)) * 64 + n0 + 4 * (lane >> 5);
#pragma unroll
    for (int g = 0; g < 4; ++g) { v2u w; w.x = pk2(v[4 * g], v[4 * g + 1]); w.y = pk2(v[4 * g + 2], v[4 * g + 3]); *(GAS v2u*)(p + 8 * g) = w; }
}
DI f32x16 zero16() { f32x16 z;
#pragma unroll
    for (int e = 0; e < 16; ++e) z[e] = 0.f;
    return z; }
struct LoraB3 { bf16x8 f[4]; };
DI void lora_issue3(Frame& F, int h, int sel, int n0, int lane, LoraB3& L) {
    const bf16* Wm = (const bf16*)(F.ws + (sel ? WS_AL : WS_WL)) + (size_t)h * HD * 64;
#pragma unroll
    for (int s = 0; s < 4; ++s) L.f[s] = *(const GAS bf16x8*)(Wm + (size_t)(n0 + (lane & 31)) * 64 + s * 16 + (lane >> 5) * 8);
}
DI int frag_off(int ri, int n0, int g, int lh) { return ((ri >> 4) * 2 + (n0 >> 5)) * 512 + (2 * (g & 1) + lh) * 128 + (ri & 15) * 8 + 4 * (g >> 1); }
DI void stg32f(bf16* Dst, int m0, int n0, int lane, const f32x16& v) {
#pragma unroll
    for (int g = 0; g < 4; ++g) { v2u w; w.x = pk2(v[4 * g], v[4 * g + 1]); w.y = pk2(v[4 * g + 2], v[4 * g + 3]); *(GAS v2u*)(Dst + frag_off(m0 + (lane & 31), n0, g, lane >> 5)) = w; }
}

DI void rw_chunk_wg3(Frame& F, int b, int c) {
    const bf16* proj = (const bf16*)(F.ws + WS_PROJ);
    const int t = F.tid >> 3, cg = F.tid & 7, lane = F.lane;
    const int sel = F.wave >> 2, qd = F.wave & 3, m0 = (qd >> 1) * 32, n0 = (qd & 1) * 32, lr = lane & 31, lh = lane >> 5;
    const bool hp = (c * CH + t) > 0;
    LAS bf16* XW = slotp(F, 0); LAS bf16* XA = slotp(F, 1);
    LAS bf16* sAt = slotp(F, 2); LAS bf16* sRt = slotp(F, 3); LAS bf16* sBt = slotp(F, 4); LAS bf16* sKt = slotp(F, 5); LAS bf16* sV = slotp(F, 6); LAS bf16* sNpb = slotp(F, 7); LAS bf16* sM1 = slotp(F, 8);
    LAS float* LW = (LAS float*)slotp(F, 9); LAS float* IC = LW + 4096; LAS float* SEG = (LAS float*)slotp(F, 15);
    LAS bf16* sN = slotp(F, 9); LAS bf16* sAak = slotp(F, 10); LAS bf16* sArb = slotp(F, 11); LAS bf16* sArk = slotp(F, 12); LAS bf16* sTa = slotp(F, 13); LAS bf16* sTb = slotp(F, 14);
    LAS bf16* sW = slotp(F, 9); LAS bf16* sU = slotp(F, 10);
    LAS float* GC = (LAS float*)(F.lds + LDSCTL_OFF + 512);
    LAS float* PAR = (LAS float*)(F.lds + PAR_OFF);
    LAS float* PW0 = SEG + 1024; LAS float* PA0 = SEG + 1536;
    RawRKV cur; rkv_issue(proj, b, 0, c, t, cg, cur);
    LoraB3 lb; lora_issue3(F, 0, sel, n0, lane, lb);
    {   const float p0 = F.k_k[F.tid], p1 = F.k_a[F.tid], p2 = F.r_k[F.tid], p3 = F.shift_mu[F.tid], p4 = F.shift_mu[512 + F.tid], p5 = F.shift_mu[1024 + F.tid], p6 = F.w0[F.tid], p7 = F.a0[F.tid];
        float xw[8], xa[8]; const size_t row = (size_t)b * T + c * CH + t;
        load_shift8(proj, row, hp, C_XW + cg * 8, F.shift_mu, xw); load_shift8(proj, row, hp, C_XA + cg * 8, F.shift_mu, xa);
        PAR[F.tid] = p0; PAR[512 + F.tid] = p1; PAR[1024 + F.tid] = p2; PAR[1536 + F.tid] = p3; PAR[2048 + F.tid] = p4; PAR[2560 + F.tid] = p5; PW0[F.tid] = p6; PA0[F.tid] = p7;
#pragma unroll
        for (int j = 0; j < 8; ++j) xw[j] = ftanh(xw[j]);
        *(LAS v4u*)(XW + t * MLD + cg * 8) = pack8(xw); *(LAS v4u*)(XA + t * MLD + cg * 8) = pack8(xa); }
    BAR();
#pragma unroll 1
    for (int h = 0; h < NH; ++h) {
        const size_t ci = ((size_t)(b * NH + h) * NCH + c) * CHUNK_ELEMS;
        const int hn = (h + 1 < NH) ? h + 1 : h;
        {
            f32x16 z = zero16();
            const LAS bf16* X = sel ? XA : XW;
#pragma unroll
            for (int s = 0; s < 4; ++s) z = MFMA32(lb.f[s], q32N(X, m0, s, lane), z);
            const LAS float* bias = (sel ? PA0 : PW0) + h * HD + n0 + 4 * lh; LAS float* dst = (sel ? IC : LW) + (m0 + lr) * 64 + n0 + 4 * lh;
            if (sel) {
#pragma unroll
                for (int g = 0; g < 4; ++g) { const f32x4 bv = *(const LAS f32x4*)(bias + 8 * g); f32x4 o;
#pragma unroll
                    for (int e = 0; e < 4; ++e) o[e] = fsigmoid(z[4 * g + e] + bv[e]);
                    *(LAS f32x4*)(dst + 8 * g) = o; }
            } else {
#pragma unroll
                for (int g = 0; g < 4; ++g) { const f32x4 bv = *(const LAS f32x4*)(bias + 8 * g); f32x4 o;
#pragma unroll
                    for (int e = 0; e < 4; ++e) { const float xs = -(z[4 * g + e] + bv[e]); const float sp = fmaxf(xs, 0.f) + __logf(1.0f + fexp(-fabsf(xs))); o[e] = -fexp(-sp - 0.5f); }
                    *(LAS f32x4*)(dst + 8 * g) = o; }
            }
        }
        BAR();
        {
            const int seg = F.wave, kc = F.lane; float pfx[8]; float run = 0.f;
#pragma unroll
            for (int j = 0; j < 8; ++j) { run += LW[(seg * 8 + j) * 64 + kc]; pfx[j] = run; }
            SEG[seg * 64 + kc] = run;
            BAR();
            float off = 0.f;
#pragma unroll
            for (int s = 0; s < 8; ++s) { const float sv = SEG[s * 64 + kc]; off += (s < seg) ? sv : 0.f; }
#pragma unroll
            for (int j = 0; j < 8; ++j) LW[(seg * 8 + j) * 64 + kc] = pfx[j] + off;
            BAR();
        }
        {
            float r8[8], k8[8], v8[8];
            shift8(cur.rc, cur.rp, hp, PAR + 1536 + h * HD + cg * 8, r8); shift8(cur.kc, cur.kp, hp, PAR + 2048 + h * HD + cg * 8, k8); shift8(cur.vc, cur.vp, hp, PAR + 2560 + h * HD + cg * 8, v8);
            float Lt[8], Lm[8], ic[8];
            lds_ld8f(LW + t * 64 + cg * 8, Lt); lds_ld8f(IC + t * 64 + cg * 8, ic);
            lds_ld8f(LW + (t > 0 ? t - 1 : 0) * 64 + cg * 8, Lm);
            if (t == 0) {
#pragma unroll
                for (int j = 0; j < 8; ++j) Lm[j] = 0.f; }
            float kkw[8], kaw[8], rkw[8]; lds_ld8f(PAR + h * HD + cg * 8, kkw); lds_ld8f(PAR + 512 + h * HD + cg * 8, kaw); lds_ld8f(PAR + 1024 + h * HD + cg * 8, rkw);
            float kk[8], ss = 0.f;
#pragma unroll
            for (int j = 0; j < 8; ++j) { kk[j] = k8[j] * kkw[j]; ss += kk[j] * kk[j]; }
            const float inv = rsqrtf(fmaxf(red8(ss), 1e-24f));
            float at[8], rt[8], bt[8], kt[8], cbp = 0.f;
#pragma unroll
            for (int j = 0; j < 8; ++j) { const float kn = kk[j] * inv; const float kh = k8[j] * (1.0f + (ic[j] - 1.0f) * kaw[j]); const float bb = kn * ic[j];
                const float em = fexp(Lm[j]), et = fexp(Lt[j]), en = fexp(-Lt[j]);
                at[j] = -kn * em; rt[j] = r8[j] * et; bt[j] = bb * en; kt[j] = kh * en; cbp += r8[j] * kh * rkw[j]; }
            const float cb = red8(cbp);
            if (cg == 0) ((float*)(F.ws + WS_CB))[((size_t)b * T + c * CH + t) * NH + h] = cb;
            if (t == 63) {
#pragma unroll
                for (int j = 0; j < 8; ++j) GC[cg * 8 + j] = fexp(Lt[j]); }
            *(LAS v4u*)(sAt + t * MLD + cg * 8) = pack8(at); *(LAS v4u*)(sRt + t * MLD + cg * 8) = pack8(rt); *(LAS v4u*)(sBt + t * MLD + cg * 8) = pack8(bt); *(LAS v4u*)(sKt + t * MLD + cg * 8) = pack8(kt);
            *(LAS v4u*)(sV + t * MLD + cg * 8) = pack8(v8);
        }
        rkv_issue(proj, b, hn, c, t, cg, cur);
        BAR();
        {
            const LAS bf16* ZA = (qd & 2) ? sRt : sAt; const LAS bf16* ZB = (qd & 1) ? sKt : sBt; LAS bf16* dst = (qd == 0) ? sN : (qd == 1) ? sAak : (qd == 2) ? sArb : sArk; const bool incl = (qd & 2) != 0;
            if (sel == 0) { f32x16 a = zero16(); mm32<false, false>(a, ZA, ZB, 32, 0, lane); st32(dst, 32, 0, lane, a); if (qd == 0) st32(sTa, 32, 0, lane, a); }
            else { const f32x16 z = zero16(); st32(dst, 0, 32, lane, z); if (qd == 0) st32(sTa, 0, 32, lane, z); }
            const int d0 = sel ? 32 : 0; f32x16 a = zero16(); mm32<false, false>(a, ZA, ZB, d0, d0, lane);
            f32x16 t0;
#pragma unroll
            for (int e = 0; e < 16; ++e) { const int n = 8 * (e >> 2) + 4 * lh + (e & 3); const bool keep = incl ? (n <= lr) : (n < lr); a[e] = keep ? a[e] : 0.f; t0[e] = a[e] + ((n == lr) ? 1.0f : 0.f); }
            st32(dst, d0, d0, lane, a); if (qd == 0) st32(sTa, d0, d0, lane, t0);
        }
        BAR();
        {
            f32x16 a = zero16();
            if (sel == 0) { mm32<false, true>(a, sN, sN, m0, n0, lane); st32(sNpb, m0, n0, lane, a); }
            else { mm32<false, true>(a, sAak, sV, m0, n0, lane); st32(sM1, m0, n0, lane, a); }
        }
        BAR();
#pragma unroll 1
        for (int it = 1; it <= 5 + MK_XIT; ++it) {
            const bool odd = it & 1;
            const LAS bf16* cT = odd ? sTa : sTb; const LAS bf16* cNp = odd ? sNpb : sN; LAS bf16* dT = odd ? sTb : sTa; LAS bf16* dNp = odd ? sN : sNpb;
            if (sel == 0) { f32x16 a; ld32(cT, m0, n0, lane, a); mm32<false, true>(a, cT, cNp, m0, n0, lane); st32(dT, m0, n0, lane, a); }
            else if (it < 5 + MK_XIT) { f32x16 a = zero16(); mm32<false, true>(a, cNp, cNp, m0, n0, lane); st32(dNp, m0, n0, lane, a); }
            BAR();
        }
        lora_issue3(F, hn, sel, n0, lane, lb);
        {
            f32x16 a = zero16();
            if (sel == 0) { mm32<false, true>(a, sTb, sAt, m0, n0, lane); st32(sW, m0, n0, lane, a); }
            else { mm32<false, true>(a, sTb, sM1, m0, n0, lane); st32(sU, m0, n0, lane, a); }
        }
        BAR();
        {
            bf16* gPT = chunk_PT(F) + ci; bf16* gQ = chunk_Q(F) + ci; bf16* gRW = chunk_RW(F) + ci; bf16* gYP = chunk_YP(F) + ci;
#pragma unroll 1
            for (int xr = 0; xr < 1 + MK_XM5; ++xr) {
            if (sel == 0) {
                f32x16 pt = zero16(); mm32<true, true>(pt, sBt, sW, m0, n0, lane);
                const float gm = GC[m0 + lr];
#pragma unroll
                for (int e = 0; e < 16; ++e) { const int n = n0 + 8 * (e >> 2) + 4 * lh + (e & 3); pt[e] = gm * (pt[e] + ((n == m0 + lr) ? 1.0f : 0.f)); }
                stg32f(gPT, m0, n0, lane, pt);
                f32x16 qq = zero16(); mm32<true, true>(qq, sU, sBt, m0, n0, lane); mm32<true, true>(qq, sV, sKt, m0, n0, lane);
#pragma unroll
                for (int g = 0; g < 4; ++g) { const f32x4 gc = *(const LAS f32x4*)(GC + n0 + 8 * g + 4 * lh);
#pragma unroll
                    for (int e = 0; e < 4; ++e) qq[4 * g + e] *= gc[e]; }
                stg32f(gQ, m0, n0, lane, qq);
            } else {
                f32x16 rw; ld32(sRt, m0, n0, lane, rw); mm32<false, true>(rw, sArb, sW, m0, n0, lane); stg32(gRW, m0, n0, lane, rw);
                f32x16 yp = zero16(); mm32<false, true>(yp, sArb, sU, m0, n0, lane); mm32<false, true>(yp, sArk, sV, m0, n0, lane); stg32(gYP, m0, n0, lane, yp);
            } }
        }
        BAR();
    }
}

constexpr int SC_D = 5, SC_SLOT = 10240;
DI void sc_issue(const bf16* gPT, const bf16* gQ, LAS unsigned char* ring, int c, int lane) {
    LAS unsigned char* dst = ring + (c % SC_D) * SC_SLOT;
#pragma unroll
    for (int blk = 0; blk < 8; ++blk) __builtin_amdgcn_global_load_lds((const unsigned*)(gPT + (size_t)c * CHUNK_ELEMS + blk * 512 + lane * 8), (LAS unsigned*)(dst + blk * 1024), 16, 0, 0);
#pragma unroll
    for (int blk = 0; blk < 2; ++blk) __builtin_amdgcn_global_load_lds((const unsigned*)(gQ + (size_t)c * CHUNK_ELEMS + blk * 512 + lane * 8), (LAS unsigned*)(dst + 8192 + blk * 1024), 16, 0, 0);
}
DI void rw_scan_task(Frame& F, int task) {
    const int chain = task >> 2, sl = task & 3, lane = F.lane, fr = lane & 15, fq = lane >> 4;
    const bf16* gPT = chunk_PT(F) + (size_t)chain * NCH * CHUNK_ELEMS;
    const bf16* gQ = chunk_Q(F) + (size_t)chain * NCH * CHUNK_ELEMS + sl * 1024;
    bf16* SB = (bf16*)(F.ws + WS_SB) + (size_t)chain * NCH * CHUNK_ELEMS + (size_t)(16 * sl + fr) * 64 + 4 * fq;
    LAS unsigned char* ring = F.lds;
    f32x4 acc[4];
#pragma unroll
    for (int nt = 0; nt < 4; ++nt) { acc[nt] = (f32x4){0.f, 0.f, 0.f, 0.f}; *(GAS v2u*)(SB + 16 * nt) = (v2u){0u, 0u}; }
#pragma unroll
    for (int c = 0; c < SC_D - 1; ++c) sc_issue(gPT, gQ, ring, c, lane);
#pragma unroll 1
    for (int c = 0; c < NCH - 1; ++c) {
        if (c + SC_D - 1 < NCH - 1) { sc_issue(gPT, gQ, ring, c + SC_D - 1, lane); asm volatile("s_waitcnt vmcnt(40)" ::: "memory"); }
        else asm volatile("s_waitcnt vmcnt(0)" ::: "memory");
        const LAS unsigned char* src = ring + (c % SC_D) * SC_SLOT + lane * 16;
        bf16x8 bq[4][2]; v4u qv[2];
#pragma unroll
        for (int nt = 0; nt < 4; ++nt)
#pragma unroll
            for (int ks = 0; ks < 2; ++ks) bq[nt][ks] = *(const LAS bf16x8*)(src + (nt * 2 + ks) * 1024);
#pragma unroll
        for (int blk = 0; blk < 2; ++blk) qv[blk] = *(const LAS v4u*)(src + 8192 + blk * 1024);
        bf16x8 a[2];
#pragma unroll
        for (int ks = 0; ks < 2; ++ks) { v4u w; w.x = pk2(acc[2 * ks][0], acc[2 * ks][1]); w.y = pk2(acc[2 * ks][2], acc[2 * ks][3]); w.z = pk2(acc[2 * ks + 1][0], acc[2 * ks + 1][1]); w.w = pk2(acc[2 * ks + 1][2], acc[2 * ks + 1][3]); a[ks] = __builtin_bit_cast(bf16x8, w); }
#pragma unroll
        for (int nt = 0; nt < 4; ++nt) { const unsigned q0 = (nt & 1) ? qv[nt >> 1].z : qv[nt >> 1].x, q1 = (nt & 1) ? qv[nt >> 1].w : qv[nt >> 1].y;
            f32x4 n = (f32x4){bflo(q0), bfhi(q0), bflo(q1), bfhi(q1)};
#pragma unroll
            for (int ks = 0; ks < 2; ++ks) n = MFMA16(bq[nt][ks], a[ks], n);
            acc[nt] = n; }
        asm volatile("s_waitcnt lgkmcnt(0)" ::: "memory");
#pragma unroll
        for (int nt = 0; nt < 4; ++nt) { v2u w; w.x = pk2(acc[nt][0], acc[nt][1]); w.y = pk2(acc[nt][2], acc[nt][3]); *(GAS v2u*)(SB + (size_t)(c + 1) * CHUNK_ELEMS + 16 * nt) = w; }
    }
    asm volatile("s_waitcnt vmcnt(0)" ::: "memory");
}

DI void rw_out_chunk(Frame& F, int b, int c) {
    const bf16* proj = (const bf16*)(F.ws + WS_PROJ);
    LAS bf16* XG = slotp(F, 0);
    rw_gate_prep(F, proj, b, c, XG);
    const int h = F.wave, r = F.lane & 31, hh = F.lane >> 5;
    const size_t ci = ((size_t)(b * NH + h) * NCH + c) * CHUNK_ELEMS;
    const bf16* gRW = chunk_RW(F) + ci; const bf16* gYP = chunk_YP(F) + ci; const bf16* gS = (const bf16*)(F.ws + WS_SB) + ci;
    const bf16* GL = (const bf16*)(F.ws + WS_GL) + (size_t)h * HD * RANK_G;
    BAR();
    bf16* mix = (bf16*)(F.ws + WS_MIX);
#pragma unroll 1
    for (int tt = 0; tt < 2; ++tt) {
        f32x16 y[2], g[2];
#pragma unroll
        for (int vt = 0; vt < 2; ++vt)
#pragma unroll
            for (int e = 0; e < 16; ++e) { y[vt][e] = 0.f; g[vt][e] = 0.f; }
#pragma unroll
        for (int s = 0; s < 4; ++s) {
            const bf16x8 bb = *(const GAS bf16x8*)(gRW + (size_t)(tt * 32 + r) * 64 + s * 16 + hh * 8);
#pragma unroll
            for (int vt = 0; vt < 2; ++vt) { const bf16x8 a = *(const GAS bf16x8*)(gS + (size_t)(vt * 32 + r) * 64 + s * 16 + hh * 8); y[vt] = MFMA32(a, bb, y[vt]); }
        }
#pragma unroll
        for (int s = 0; s < 10; ++s) {
            const bf16x8 bb = *(const LAS bf16x8*)(XG + (tt * 32 + r) * GLD + s * 16 + hh * 8);
#pragma unroll
            for (int vt = 0; vt < 2; ++vt) { const bf16x8 a = *(const GAS bf16x8*)(GL + (size_t)(vt * 32 + r) * RANK_G + s * 16 + hh * 8); g[vt] = MFMA32(a, bb, g[vt]); }
        }
        const int t = tt * 32 + r, tau = c * CH + t; const size_t row = (size_t)b * T + tau; const bool hp = tau > 0;
        float sum = 0.f;
#pragma unroll
        for (int vt = 0; vt < 2; ++vt)
#pragma unroll
            for (int q = 0; q < 4; ++q) { const v2u w = *(const GAS v2u*)(gYP + (size_t)t * 64 + vt * 32 + q * 8 + hh * 4);
                y[vt][4 * q + 0] += bflo(w.x); y[vt][4 * q + 1] += bfhi(w.x); y[vt][4 * q + 2] += bflo(w.y); y[vt][4 * q + 3] += bfhi(w.y);
                sum += (y[vt][4 * q + 0] + y[vt][4 * q + 1]) + (y[vt][4 * q + 2] + y[vt][4 * q + 3]); }
        sum += __shfl_xor(sum, 32);
        const float mean = sum * (1.f / 64.f); float sq = 0.f;
#pragma unroll
        for (int vt = 0; vt < 2; ++vt)
#pragma unroll
            for (int e = 0; e < 16; ++e) { const float d = y[vt][e] - mean; sq += d * d; }
        sq += __shfl_xor(sq, 32);
        const float rstd = rsqrtf(sq * (1.f / 64.f) + GN_EPS);
        const float cb = ((const float*)(F.ws + WS_CB))[row * NH + h];
#pragma unroll
        for (int vt = 0; vt < 2; ++vt)
#pragma unroll
            for (int q = 0; q < 4; ++q) { const int v0 = vt * 32 + q * 8 + hh * 4, col = C_V + h * HD + v0;
                const v2u cw = *(const GAS v2u*)(proj + row * PROJ_LD + col); v2u pw = *(const GAS v2u*)(proj + (row - (hp ? 1 : 0)) * PROJ_LD + col); if (!hp) pw = (v2u){0u, 0u};
                const f32x4 mu = *(const GAS f32x4*)(F.shift_mu + (col - CONV_COLS)), lg = *(const GAS f32x4*)(F.ln_x_g + h * HD + v0), lb = *(const GAS f32x4*)(F.ln_x_b + h * HD + v0);
                const float cu[4] = {bflo(cw.x), bfhi(cw.x), bflo(cw.y), bfhi(cw.y)}, pr[4] = {bflo(pw.x), bfhi(pw.x), bflo(pw.y), bfhi(pw.y)};
                float o[4];
#pragma unroll
                for (int e = 0; e < 4; ++e) { const float vv = cu[e] + mu[e] * (pr[e] - cu[e]); o[e] = ((y[vt][4 * q + e] - mean) * rstd * lg[e] + lb[e] + cb * vv) * g[vt][4 * q + e]; }
                v2u ow; ow.x = pk2(o[0], o[1]); ow.y = pk2(o[2], o[3]);
                *(GAS v2u*)(mix + row * D + CONVD + h * HD + v0) = ow; }
    }
    BAR();
}
#ifndef MK_SKIP2
#define MK_SKIP2 0
#endif
#ifndef MK_SKIP4
#define MK_SKIP4 0
#endif
#ifndef MK_XIT
#define MK_XIT 0
#endif
#ifndef MK_XM5
#define MK_XM5 0
#endif
#ifndef MK_DUP
#define MK_DUP -1
#endif
constexpr int NPH = 10;
struct Args { const float* in[24]; float* out; unsigned char* ws; int ph_lo, ph_hi, li, pad; };
__global__ void __launch_bounds__(NWAVES * 64, 2) mk_fwd(Args args) {
    extern __shared__ __attribute__((aligned(16))) unsigned char lds[];
    Frame F;
    F.lds = (LAS unsigned char*)lds;
    F.MISC = (volatile LAS unsigned*)(F.lds + LDSCTL_OFF);
    F.tid = threadIdx.x; F.lane = F.tid & 63; F.wave = __builtin_amdgcn_readfirstlane(F.tid >> 6);
    F.G = gridDim.x; { const int bx = blockIdx.x; F.vcu = (F.G % 8 == 0) ? (bx % 8) * (F.G / 8) + bx / 8 : bx; }
    F.ws = args.ws; F.ctl = (gu32*)(args.ws + WS_CTL); F.out = args.out;
    F.x = args.in[0]; F.p = args.in[1]; F.norm_mix_g = args.in[2]; F.w_in = args.in[3]; F.conv_w = args.in[4]; F.shift_mu = args.in[5]; F.w_lora_up = args.in[6]; F.w0 = args.in[7];
    F.a_lora_up = args.in[8]; F.a0 = args.in[9]; F.g_lora_up = args.in[10]; F.k_k = args.in[11]; F.k_a = args.in[12]; F.r_k = args.in[13]; F.ln_x_g = args.in[14]; F.ln_x_b = args.in[15];
    F.w_out = args.in[16]; F.norm_mlp_g = args.in[17]; F.w_up = args.in[18]; F.w_down = args.in[19]; F.norm_ple_g = args.in[20]; F.w_ple_gate = args.in[21]; F.w_ple_proj = args.in[22]; F.norm_final_g = args.in[23];
    for (int u = F.tid; u < (LDS_BYTES - LDSCTL_OFF) / 4; u += NWAVES * 64) ((LAS unsigned*)(F.lds + LDSCTL_OFF))[u] = 0u;
    __syncthreads();
    XcdBarrier bar; bar.bar = (unsigned*)(F.ctl + CW_BAR) + args.li * XCD_BAR_WORDS; bar.x = 0; bar.st = nullptr;
    if (N_LAUNCHES == 1) bar = xcd_barrier_post((unsigned*)(F.ctl + CW_BAR), F.MISC + 8);
    const int lo = args.ph_lo, hi = args.ph_hi;
#define IN(k) (lo <= (k) && (k) < hi)
#define SEAM(k) do { if (IN(k) && IN((k) + 1)) xcd_barrier(bar); } while (0)
    bf16* ABUF = (bf16*)(F.ws + WS_ABUF); bf16* PROJ = (bf16*)(F.ws + WS_PROJ); bf16* MIX = (bf16*)(F.ws + WS_MIX); bf16* PLEB = (bf16*)(F.ws + WS_PLE); bf16* HSQ = (bf16*)(F.ws + WS_HSQ); bf16* PB = (bf16*)(F.ws + WS_PB);
    float* SSQ1 = (float*)(F.ws + WS_SSQ1); float* SSQ2 = (float*)(F.ws + WS_SSQ2); float* SSQ3 = (float*)(F.ws + WS_SSQ3);

    if (IN(0)) for (int rep = 0; rep < (MK_DUP == 0 ? 2 : 1); ++rep) { p0_prologue(F); } SEAM(0);
    if (IN(1)) for (int rep = 0; rep < (MK_DUP == 1 ? 2 : 1); ++rep) {
        { pg8::Gemm g{ABUF, (const bf16*)(F.ws + WS_WIN), M, IN_PAD, D}; pg8::StaticOrder S; S.init(M, IN_PAD, F.G, (int)blockIdx.x);
          pg8::EpiBf16G E{PROJ, PROJ_LD, IN_COLS};
          pg8::gemm_phase<pg8::EpiBf16G, pg8::StaticOrder, PG8_ALIGN, PG8_SP2>(F.lds, g, S, E); }
        { pg8::Gemm g{PB, (const bf16*)(F.ws + WS_WPLE), M, D, PLE}; pg8::StaticOrder S; S.init(M, D, F.G, (int)blockIdx.x);
          pg8::EpiBf16G E{PLEB, D, D};
          pg8::gemm_phase<pg8::EpiBf16G, pg8::StaticOrder, PG8_ALIGN, PG8_SP2>(F.lds, g, S, E); }
    } SEAM(1);
#if MK_NAIVE
    if (IN(2)) {
        if (F.vcu < BATCH * NH) rwkv_naive_chain(F, F.vcu);
        else conv_wave(F, (F.vcu - BATCH * NH) * NWAVES + F.wave, (F.G - BATCH * NH) * NWAVES);
    } SEAM(2); SEAM(3); SEAM(4);
#else
    if (IN(2)) for (int rep = 0; rep < (MK_DUP == 2 ? 2 : 1); ++rep) { for (int bc = F.vcu; bc < BATCH * NCH; bc += F.G) { if (!MK_SKIP2) rw_chunk_wg3(F, bc / NCH, bc % NCH); } } SEAM(2);
    if (IN(3)) for (int rep = 0; rep < (MK_DUP == 3 ? 2 : 1); ++rep) {
        constexpr int NTASK = BATCH * NH * 4;
        if (F.vcu < NTASK && F.wave == 0) rw_scan_task(F, F.vcu);
        else conv_wave(F, F.vcu < NTASK ? F.vcu * (NWAVES - 1) + F.wave - 1 : NTASK * (NWAVES - 1) + (F.vcu - NTASK) * NWAVES + F.wave, F.G * NWAVES - NTASK);
    } SEAM(3);
    if (IN(4)) for (int rep = 0; rep < (MK_DUP == 4 ? 2 : 1); ++rep) { for (int bc = F.vcu; bc < BATCH * NCH; bc += F.G) { if (!MK_SKIP4) rw_out_chunk(F, bc / NCH, bc % NCH); } } SEAM(4);
#endif
    if (IN(5)) for (int rep = 0; rep < (MK_DUP == 5 ? 2 : 1); ++rep) {
        pg8::Gemm g{MIX, (const bf16*)(F.ws + WS_WOUT), M, D, D}; pg8::StaticOrder S; S.init(M, D, F.G, (int)blockIdx.x);
        pg8::EpiRes E{F.x, F.out, ABUF, SSQ1, D};
        pg8::gemm_phase<pg8::EpiRes, pg8::StaticOrder, false, PG8_SP2>(F.lds, g, S, E);
    } SEAM(5);
    if (IN(6)) for (int rep = 0; rep < (MK_DUP == 6 ? 2 : 1); ++rep) {
        pg8::Gemm g{ABUF, (const bf16*)(F.ws + WS_WUP), M, FF, D}; pg8::StaticOrder S; S.init(M, FF, F.G, (int)blockIdx.x);
        pg8::EpiSqRelu E{HSQ, FF, SSQ1, 1.f / D, RMS_EPS};
        pg8::gemm_phase<pg8::EpiSqRelu, pg8::StaticOrder, PG8_ALIGN, PG8_SP2>(F.lds, g, S, E);
    } SEAM(6);
    if (IN(7)) {
        pg8::Gemm g{HSQ, (const bf16*)(F.ws + WS_WDN), M, D, FF}; pg8::StaticOrder S; S.init(M, D, F.G, (int)blockIdx.x);
        pg8::EpiRes E{F.out, F.out, ABUF, SSQ2, D};
        pg8::gemm_phase<pg8::EpiRes, pg8::StaticOrder, false, PG8_SP2>(F.lds, g, S, E);
    } SEAM(7);
    if (IN(8)) {
        pg8::Gemm g{ABUF, (const bf16*)(F.ws + WS_WG), M, D, D}; pg8::StaticOrder S; S.init(M, D, F.G, (int)blockIdx.x);
        pg8::EpiGate E{F.out, PLEB, SSQ2, SSQ3, D, 1.f / D, RMS_EPS};
        pg8::gemm_phase<pg8::EpiGate, pg8::StaticOrder, false, PG8_SP2>(F.lds, g, S, E);
    } SEAM(8);
    if (IN(9)) { final_norm(F); }
#undef IN
#undef SEAM
}

extern "C" void kernel_launch(void* const* d_in, const int* in_sizes, int n_in, void* d_out, int out_size, void* d_ws, size_t ws_size, hipStream_t stream) {
    static int grid = 0;
    if (grid == 0) {
        if (n_in != 24 || in_sizes[0] != M * D || out_size != M * D || ws_size < WS_END) { fprintf(stderr, "kernel_launch: unexpected shapes: n_in %d in0 %d out %d ws %zu\n", n_in, n_in > 0 ? in_sizes[0] : -1, out_size, ws_size); grid = -1; return; }
        int dev = 0, cus = 0, per_cu = 0;
        if (hipGetDevice(&dev) != hipSuccess || hipDeviceGetAttribute(&cus, hipDeviceAttributeMultiprocessorCount, dev) != hipSuccess) { fprintf(stderr, "kernel_launch: device query failed\n"); grid = -1; return; }
        if (hipFuncSetAttribute((const void*)mk_fwd, hipFuncAttributeMaxDynamicSharedMemorySize, LDS_BYTES) != hipSuccess) { fprintf(stderr, "kernel_launch: hipFuncSetAttribute failed\n"); grid = -1; return; }
        if (hipOccupancyMaxActiveBlocksPerMultiprocessor(&per_cu, (const void*)mk_fwd, NWAVES * 64, LDS_BYTES) != hipSuccess || per_cu < 1)
            fprintf(stderr, "kernel_launch: note: occupancy query reports %d workgroups per CU\n", per_cu);
        (void)hipGetLastError();
        grid = cus;
        if (grid != 256) { fprintf(stderr, "kernel_launch: this kernel needs a 256-CU device (got %d)\n", grid); grid = -1; return; }
    }
    if (grid < 0) return;
    if (hipMemsetAsync((char*)d_ws + WS_CTL, 0, CTL_ZERO_BYTES, stream) != hipSuccess) { fprintf(stderr, "kernel_launch: hipMemsetAsync failed\n"); return; }
    Args a{};
    for (int i = 0; i < 24; ++i) a.in[i] = (const float*)d_in[i];
    a.out = (float*)d_out; a.ws = (unsigned char*)d_ws;
    if (N_LAUNCHES == 1) { a.ph_lo = 0; a.ph_hi = NPH; a.li = 0; hipLaunchKernelGGL(mk_fwd, dim3(grid), dim3(NWAVES * 64), LDS_BYTES, stream, a); }
    else for (int li = 0; li < NPH; ++li) { a.ph_lo = li; a.ph_hi = li + 1; a.li = 0; hipLaunchKernelGGL(mk_fwd, dim3(grid), dim3(NWAVES * 64), LDS_BYTES, stream, a); }
    const hipError_t le = hipPeekAtLastError();
    if (le != hipSuccess) fprintf(stderr, "kernel_launch: launch failed: %s\n", hipGetErrorName(le));
}
```

```cpp
#include <hip/hip_runtime.h>
#include <cstdio>
#include <cstdint>

namespace pg8 {
#define PG8_LAS __attribute__((address_space(3)))
typedef unsigned short bf16_t;
typedef short bf16x8 __attribute__((ext_vector_type(8)));
typedef float f32x4 __attribute__((ext_vector_type(4)));
typedef unsigned u32x4 __attribute__((ext_vector_type(4)));
constexpr int BM = 256, BK = 64, HALF = 128, HTB = HALF * BK * 2  , STAGE_BYTES = 8 * HTB, NXCD = 8, WGM = 8;

__host__ __device__ __forceinline__ int lds_byte(int r, int c) { const int st = (r >> 4) * 2 + (c >> 5), rr = r & 15, cc = c & 31, ob = rr * 64 + cc * 2; return st * 1024 + (ob ^ (((ob >> 9) & 1) << 5)); }
__host__ __device__ __forceinline__ void stage_rc(int b, int& R, int& C) { const int st = b / 1024, sb = b % 1024, swz = sb ^ (((sb >> 9) & 1) << 5); R = (st >> 1) * 16 + swz / 64; C = (st & 1) * 32 + (swz % 64) / 2; }
__host__ __device__ __forceinline__ int perm32(int rho) { const int n = rho >> 4, i = rho & 15; return 8 * (i >> 2) + 4 * n + (i & 3); }

struct Unit { int pm, pn; };
struct Gemm { const bf16_t* A; const bf16_t* Bt; int M, N, K; };

struct StaticOrder {
    int nM, nN, nwg, G, c;
    __host__ __device__ void init(int M, int N, int G_, int c_) { nM = M / BM; nN = N / BM; nwg = nM * nN; G = G_; c = c_; }
    __host__ __device__ bool next(int i, Unit& u) const {
        const long L = (long)i * G + c; if (L >= nwg) return false;
        int wgid = (int)L; { const int q = nwg / NXCD, r = nwg % NXCD, xcd = wgid % NXCD, off = wgid / NXCD; wgid = (xcd < r ? xcd * (q + 1) : r * (q + 1) + (xcd - r) * q) + off; }
        const int nig = WGM * nN, gid = wgid / nig, fm = gid * WGM, gsz = (nM - fm) < WGM ? (nM - fm) : WGM;
        u.pm = fm + ((wgid % nig) % gsz); u.pn = (wgid % nig) / gsz; return true;
    }
    __device__ __forceinline__ void a_ready(const Unit&) const {}
    __device__ __forceinline__ void done(const Unit&) const {}
};

__device__ __forceinline__ unsigned cvt_pk_bf16(float lo, float hi) { unsigned r; asm volatile("v_cvt_pk_bf16_f32 %0, %1, %2" : "=v"(r) : "v"(lo), "v"(hi)); return r; }
typedef float f32x2 __attribute__((ext_vector_type(2)));

typedef unsigned u32x2 __attribute__((ext_vector_type(2)));
struct EpiBf16G {
    static constexpr bool PERM = true, AFTER_DRAIN = false;
    bf16_t* O; int ldc; int ncols;
    __device__ __forceinline__ void operator()(const f32x4 (&acc)[2][2][4][2], const Unit& u, int wr, int wc, int fr, int fq) const {
        const int row0 = u.pm * BM + wr * 64 + fr, col0 = u.pn * BM + wc * 32 + 8 * fq;
#pragma unroll
        for (int ai = 0; ai < 2; ++ai)
#pragma unroll
            for (int m = 0; m < 4; ++m) { bf16_t* rowp = O + (size_t)(row0 + ai * HALF + m * 16) * ldc + col0;
#pragma unroll
                for (int bj = 0; bj < 2; ++bj) { if (col0 + bj * HALF < ncols) { const f32x4 v0 = acc[ai][bj][m][0], v1 = acc[ai][bj][m][1];
                    u32x4 w; w.x = cvt_pk_bf16(v0[0], v0[1]); w.y = cvt_pk_bf16(v0[2], v0[3]); w.z = cvt_pk_bf16(v1[0], v1[1]); w.w = cvt_pk_bf16(v1[2], v1[3]);
                    *(u32x4*)(rowp + bj * HALF) = w; } } }
    }
};
struct EpiSqRelu {
    static constexpr bool PERM = true, AFTER_DRAIN = false;
    bf16_t* O; int ldc; const float* ssq; float inv_n, eps;
    __device__ __forceinline__ void operator()(const f32x4 (&acc)[2][2][4][2], const Unit& u, int wr, int wc, int fr, int fq) const {
        const int row0 = u.pm * BM + wr * 64 + fr, col0 = u.pn * BM + wc * 32 + 8 * fq;
#pragma unroll
        for (int ai = 0; ai < 2; ++ai)
#pragma unroll
            for (int m = 0; m < 4; ++m) { const int row = row0 + ai * HALF + m * 16; bf16_t* rowp = O + (size_t)row * ldc + col0;
                const f32x4 s4 = *(const f32x4*)(ssq + (size_t)row * 4); const float rs = rsqrtf(((s4[0] + s4[1]) + (s4[2] + s4[3])) * inv_n + eps);
#pragma unroll
                for (int bj = 0; bj < 2; ++bj) { f32x4 v0 = acc[ai][bj][m][0] * rs, v1 = acc[ai][bj][m][1] * rs;
#pragma unroll
                    for (int e = 0; e < 4; ++e) { const float a = fmaxf(v0[e], 0.f), b = fmaxf(v1[e], 0.f); v0[e] = a * a; v1[e] = b * b; }
                    u32x4 w; w.x = cvt_pk_bf16(v0[0], v0[1]); w.y = cvt_pk_bf16(v0[2], v0[3]); w.z = cvt_pk_bf16(v1[0], v1[1]); w.w = cvt_pk_bf16(v1[2], v1[3]);
                    *(u32x4*)(rowp + bj * HALF) = w; } }
    }
};
struct EpiRes {
    static constexpr bool PERM = false, AFTER_DRAIN = true;
    const float* base; float* out; bf16_t* hb; float* ssq; int ldc;
    __device__ __forceinline__ void fused(f32x4 (&acc)[2][2][4][2], const Unit& u, int wr, int wc, int fr, int fq, PG8_LAS unsigned char* lds, int wid, int lane) const {
        PG8_LAS float* P = (PG8_LAS float*)lds;
        const int col0 = u.pn * BM + wc * 32 + 4 * fq;
#pragma unroll
        for (int ai = 0; ai < 2; ++ai)
#pragma unroll
            for (int m = 0; m < 4; ++m) { const int r = ai * HALF + wr * 64 + m * 16 + fr; const size_t off = (size_t)(u.pm * BM + r) * ldc + col0; float ss = 0.f;
#pragma unroll
                for (int bj = 0; bj < 2; ++bj)
#pragma unroll
                    for (int n = 0; n < 2; ++n) { const size_t o2 = off + bj * HALF + n * 16; const f32x4 bs = *(const f32x4*)(base + o2); const f32x4 h = bs + acc[ai][bj][m][n];
                        *(f32x4*)(out + o2) = h; ss += (h[0] * h[0] + h[1] * h[1]) + (h[2] * h[2] + h[3] * h[3]);
                        u32x2 w; w.x = cvt_pk_bf16(h[0], h[1]); w.y = cvt_pk_bf16(h[2], h[3]); *(u32x2*)(hb + o2) = w; }
                ss += __shfl_xor(ss, 16); ss += __shfl_xor(ss, 32);
                if (fq == 0) P[r * 4 + wc] = ss;
                asm volatile("" ::: "memory"); }
        asm volatile("s_waitcnt lgkmcnt(0)" ::: "memory"); __builtin_amdgcn_s_barrier(); asm volatile("" ::: "memory");
        const int tid = wid * 64 + lane;
        if (tid < 256) { const f32x4 p = *(const PG8_LAS f32x4*)(P + tid * 4); ssq[(size_t)(u.pm * BM + tid) * 4 + u.pn] = (p[0] + p[1]) + (p[2] + p[3]); }
        asm volatile("s_waitcnt lgkmcnt(0)" ::: "memory"); __builtin_amdgcn_s_barrier(); asm volatile("" ::: "memory");
    }
};
struct EpiGate {
    static constexpr bool PERM = false, AFTER_DRAIN = true;
    float* io; const bf16_t* ple; const float* ssq_in; float* ssq_out; int ldc; float inv_n, eps;
    __device__ __forceinline__ void fused(f32x4 (&acc)[2][2][4][2], const Unit& u, int wr, int wc, int fr, int fq, PG8_LAS unsigned char* lds, int wid, int lane) const {
        PG8_LAS float* P = (PG8_LAS float*)lds;
        const int col0 = u.pn * BM + wc * 32 + 4 * fq;
#pragma unroll
        for (int ai = 0; ai < 2; ++ai)
#pragma unroll
            for (int m = 0; m < 4; ++m) { const int r = ai * HALF + wr * 64 + m * 16 + fr; const size_t off = (size_t)(u.pm * BM + r) * ldc + col0; float ss = 0.f;
                const f32x4 s4 = *(const f32x4*)(ssq_in + (size_t)(u.pm * BM + r) * 4); const float rs = rsqrtf(((s4[0] + s4[1]) + (s4[2] + s4[3])) * inv_n + eps);
#pragma unroll
                for (int bj = 0; bj < 2; ++bj)
#pragma unroll
                    for (int n = 0; n < 2; ++n) { const size_t o2 = off + bj * HALF + n * 16; const f32x4 h2 = *(const f32x4*)(io + o2); const u32x2 pw = *(const u32x2*)(ple + o2);
                        f32x4 pl; pl[0] = __uint_as_float(pw.x << 16); pl[1] = __uint_as_float(pw.x & 0xffff0000u); pl[2] = __uint_as_float(pw.y << 16); pl[3] = __uint_as_float(pw.y & 0xffff0000u);
                        f32x4 h; const f32x4 a = acc[ai][bj][m][n] * rs;
#pragma unroll
                        for (int e = 0; e < 4; ++e) { const float g = 1.0f / (1.0f + __expf(-a[e])); h[e] = h2[e] + g * pl[e]; }
                        *(f32x4*)(io + o2) = h; ss += (h[0] * h[0] + h[1] * h[1]) + (h[2] * h[2] + h[3] * h[3]); }
                ss += __shfl_xor(ss, 16); ss += __shfl_xor(ss, 32);
                if (fq == 0) P[r * 4 + wc] = ss;
                asm volatile("" ::: "memory"); }
        asm volatile("s_waitcnt lgkmcnt(0)" ::: "memory"); __builtin_amdgcn_s_barrier(); asm volatile("" ::: "memory");
        const int tid = wid * 64 + lane;
        if (tid < 256) { const f32x4 p = *(const PG8_LAS f32x4*)(P + tid * 4); ssq_out[(size_t)(u.pm * BM + tid) * 4 + u.pn] = (p[0] + p[1]) + (p[2] + p[3]); }
        asm volatile("s_waitcnt lgkmcnt(0)" ::: "memory"); __builtin_amdgcn_s_barrier(); asm volatile("" ::: "memory");
    }
};


template <class Epi, class Sched, bool ALIGN_EPI = false, bool SP2 = false>
__device__ __forceinline__ void gemm_phase(PG8_LAS unsigned char* lds, const Gemm g, const Sched& S, const Epi& E) {
    const int tid = threadIdx.x, wid = __builtin_amdgcn_readfirstlane(tid >> 6), lane = tid & 63, wr = wid >> 2, wc = wid & 3, fr = lane & 15, fq = lane >> 4;
    const int K = g.K, nt = K / BK;
    unsigned voffA[2], voffB[2];
#pragma unroll
    for (int i = 0; i < 2; ++i) { int R, C; stage_rc(tid * 16 + i * 8192, R, C); const int Rb = Epi::PERM ? ((R & ~31) + perm32(R & 31)) : R;
        voffA[i] = (unsigned)(R * K + C) * 2u; voffB[i] = (unsigned)(Rb * K + C) * 2u; }
    const size_t kstep = (size_t)(BK * 2);
    const size_t hstep = (size_t)HALF * K * 2;
    const size_t tstep = 2 * hstep;
    const unsigned ldsw = (unsigned)wid * 1024u;
    const int aoff = lds_byte(wr * 64 + fr, fq * 8), boff = lds_byte(wc * 32 + fr, fq * 8);
#define PG8_SA(b, h) (((b) * 2 + (h)) * HTB)
#define PG8_SB(b, h) ((4 + (b) * 2 + (h)) * HTB)
#define PG8_STAGE(bufoff, gbase, voff) do { _Pragma("unroll") for (int _i = 0; _i < 2; ++_i) \
        __builtin_amdgcn_global_load_lds((const unsigned*)((const char*)(gbase) + (voff)[_i]), (PG8_LAS unsigned*)(lds + (bufoff) + ldsw + _i * 8192), 16, 0, 0); } while (0)
#define PG8_LDA(dst, b, h) do { _Pragma("unroll") for (int m = 0; m < 4; ++m) _Pragma("unroll") for (int k = 0; k < 2; ++k) dst[m][k] = *(const PG8_LAS bf16x8*)(lds + PG8_SA(b, h) + aoff + m * 2048 + k * 1024); } while (0)
#define PG8_LDB(dst, b, h) do { _Pragma("unroll") for (int n = 0; n < 2; ++n) _Pragma("unroll") for (int k = 0; k < 2; ++k) dst[n][k] = *(const PG8_LAS bf16x8*)(lds + PG8_SB(b, h) + boff + n * 2048 + k * 1024); } while (0)
#define PG8_MMA(ai, bj, At, Bt) do { __builtin_amdgcn_s_setprio(1); _Pragma("unroll") for (int m = 0; m < 4; ++m) _Pragma("unroll") for (int n = 0; n < 2; ++n) _Pragma("unroll") for (int k = 0; k < 2; ++k) \
        acc[ai][bj][m][n] = __builtin_amdgcn_mfma_f32_16x16x32_bf16(Bt[n][k], At[m][k], acc[ai][bj][m][n], 0, 0, 0); __builtin_amdgcn_s_setprio(0); } while (0)
#define PG8_WAIT_V(n) asm volatile("s_waitcnt vmcnt(" #n ")" ::: "memory")
#define PG8_WAIT_L(n) asm volatile("s_waitcnt lgkmcnt(" #n ")" ::: "memory")
#define PG8_BAR __builtin_amdgcn_s_barrier()
#define PG8_SCHED __builtin_amdgcn_sched_barrier(0)
    Unit cur, nxt; int ui = 0;
    if (!S.next(0, cur)) return;
    f32x4 acc[2][2][4][2];
#pragma unroll
    for (int a = 0; a < 2; ++a)
#pragma unroll
        for (int b = 0; b < 2; ++b)
#pragma unroll
            for (int m = 0; m < 4; ++m)
#pragma unroll
                for (int n = 0; n < 2; ++n) acc[a][b][m][n] = (f32x4){0.f, 0.f, 0.f, 0.f};
    bf16x8 At[4][2], B0[2][2], B1[2][2];
    const char* cA = (const char*)g.A + (size_t)cur.pm * tstep; const char* cB = (const char*)g.Bt + (size_t)cur.pn * tstep;
    S.a_ready(cur);
    if constexpr (SP2) {
        PG8_STAGE(PG8_SB(0, 0), cB, voffB); PG8_STAGE(PG8_SB(0, 1), cB + hstep, voffB); PG8_STAGE(PG8_SA(0, 0), cA, voffA); PG8_STAGE(PG8_SA(0, 1), cA + hstep, voffA);
        if (wr == 1) PG8_BAR;
        PG8_WAIT_V(2); PG8_BAR;
        PG8_STAGE(PG8_SB(1, 0), cB + kstep, voffB); PG8_STAGE(PG8_SA(1, 0), cA + kstep, voffA); PG8_STAGE(PG8_SB(1, 1), cB + hstep + kstep, voffB);
        PG8_WAIT_V(6); PG8_BAR;
    } else {
        PG8_STAGE(PG8_SB(0, 0), cB, voffB); PG8_STAGE(PG8_SA(0, 0), cA, voffA); PG8_STAGE(PG8_SB(0, 1), cB + hstep, voffB); PG8_STAGE(PG8_SA(0, 1), cA + hstep, voffA);
        if (wr == 1) PG8_BAR;
        PG8_WAIT_V(4); PG8_BAR;
        PG8_STAGE(PG8_SB(1, 0), cB + kstep, voffB); PG8_STAGE(PG8_SA(1, 0), cA + kstep, voffA); PG8_STAGE(PG8_SB(1, 1), cB + hstep + kstep, voffB);
        PG8_WAIT_V(6); PG8_BAR;
    }
    for (;;) {
        const bool has_next = S.next(ui + 1, nxt);
        const char* nA = has_next ? (const char*)g.A + (size_t)nxt.pm * tstep : cA; const char* nB = has_next ? (const char*)g.Bt + (size_t)nxt.pn * tstep : cB;
        for (int t = 0; t < nt; t += 2) {
            const bool last = (t == nt - 2);
            const char* a1 = cA + (size_t)(t + 1) * kstep;
            const char* a2 = last ? nA : cA + (size_t)(t + 2) * kstep; const char* b2 = last ? nB : cB + (size_t)(t + 2) * kstep;
            const char* a3 = a2 + kstep; const char* b3 = b2 + kstep;
            if (last && has_next) S.a_ready(nxt);
            if constexpr (SP2) {
            PG8_LDB(B0, 0, 0); PG8_LDB(B1, 0, 1); PG8_SCHED; PG8_LDA(At, 0, 0); PG8_STAGE(PG8_SA(1, 1), a1 + hstep, voffA);
            PG8_WAIT_V(8); PG8_WAIT_L(0); PG8_BAR; PG8_MMA(0, 0, At, B0); PG8_MMA(0, 1, At, B1); PG8_BAR; PG8_SCHED;
            PG8_LDA(At, 0, 1); PG8_STAGE(PG8_SB(0, 0), b2, voffB); PG8_STAGE(PG8_SB(0, 1), b2 + hstep, voffB); PG8_STAGE(PG8_SA(0, 0), a2, voffA);
            PG8_WAIT_V(8); PG8_WAIT_L(0); PG8_BAR; PG8_MMA(1, 0, At, B0); PG8_MMA(1, 1, At, B1); PG8_BAR; PG8_SCHED;
            PG8_LDB(B0, 1, 0); PG8_LDB(B1, 1, 1); PG8_SCHED; PG8_LDA(At, 1, 0); PG8_STAGE(PG8_SA(0, 1), a2 + hstep, voffA);
            PG8_WAIT_V(8); PG8_WAIT_L(0); PG8_BAR; PG8_MMA(0, 0, At, B0); PG8_MMA(0, 1, At, B1); PG8_BAR; PG8_SCHED;
            PG8_LDA(At, 1, 1); PG8_STAGE(PG8_SB(1, 0), b3, voffB); PG8_STAGE(PG8_SB(1, 1), b3 + hstep, voffB); PG8_STAGE(PG8_SA(1, 0), a3, voffA);
            PG8_WAIT_V(8); PG8_WAIT_L(0); PG8_BAR; PG8_MMA(1, 0, At, B0); PG8_MMA(1, 1, At, B1); PG8_BAR; PG8_SCHED;
            } else {
            PG8_LDB(B0, 0, 0); PG8_SCHED; PG8_LDA(At, 0, 0); PG8_STAGE(PG8_SA(1, 1), a1 + hstep, voffA);
            PG8_WAIT_L(8); PG8_BAR; PG8_WAIT_L(0); PG8_MMA(0, 0, At, B0); PG8_BAR; PG8_SCHED;
            PG8_LDB(B1, 0, 1); PG8_STAGE(PG8_SB(0, 0), b2, voffB);
            PG8_BAR; PG8_WAIT_L(0); PG8_MMA(0, 1, At, B1); PG8_BAR;
            PG8_LDA(At, 0, 1); PG8_STAGE(PG8_SA(0, 0), a2, voffA);
            PG8_BAR; PG8_WAIT_L(0); PG8_MMA(1, 0, At, B0); PG8_BAR; PG8_SCHED;
            PG8_STAGE(PG8_SB(0, 1), b2 + hstep, voffB);
            PG8_WAIT_V(6); PG8_BAR; PG8_MMA(1, 1, At, B1); PG8_BAR;
            PG8_LDB(B0, 1, 0); PG8_SCHED; PG8_LDA(At, 1, 0); PG8_STAGE(PG8_SA(0, 1), a2 + hstep, voffA);
            PG8_WAIT_L(8); PG8_BAR; PG8_WAIT_L(0); PG8_MMA(0, 0, At, B0); PG8_BAR; PG8_SCHED;
            PG8_LDB(B1, 1, 1); PG8_STAGE(PG8_SB(1, 0), b3, voffB);
            PG8_BAR; PG8_WAIT_L(0); PG8_MMA(0, 1, At, B1); PG8_BAR;
            PG8_LDA(At, 1, 1); PG8_STAGE(PG8_SA(1, 0), a3, voffA);
            PG8_BAR; PG8_WAIT_L(0); PG8_MMA(1, 0, At, B0); PG8_BAR; PG8_SCHED;
            PG8_STAGE(PG8_SB(1, 1), b3 + hstep, voffB);
            PG8_WAIT_V(6); PG8_BAR; PG8_MMA(1, 1, At, B1); PG8_BAR;
            }
        }
        if constexpr (ALIGN_EPI) { if (wr == 0) PG8_BAR; }
        if constexpr (!Epi::AFTER_DRAIN) { E(acc, cur, wr, wc, fr, fq); S.done(cur); }
        if (!has_next) break;
#pragma unroll
        for (int a = 0; a < 2; ++a)
#pragma unroll
            for (int b = 0; b < 2; ++b)
#pragma unroll
                for (int m = 0; m < 4; ++m)
#pragma unroll
                    for (int n = 0; n < 2; ++n) acc[a][b][m][n] = (f32x4){0.f, 0.f, 0.f, 0.f};
        cur = nxt; cA = nA; cB = nB; ++ui;
        if constexpr (ALIGN_EPI) { if (wr == 1) PG8_BAR; }
    }
    PG8_WAIT_V(0);
    if constexpr (!ALIGN_EPI) { if (wr == 0) PG8_BAR; }
    PG8_BAR;
    if constexpr (Epi::AFTER_DRAIN) { E.fused(acc, cur, wr, wc, fr, fq, lds, wid, lane); S.done(cur); }
#undef PG8_SA
#undef PG8_SB
#undef PG8_STAGE
#undef PG8_LDA
#undef PG8_LDB
#undef PG8_MMA
#undef PG8_WAIT_V
#undef PG8_WAIT_L
#undef PG8_BAR
#undef PG8_SCHED
}
}

#ifndef PG8_SP2
#define PG8_SP2 true
#endif
#ifndef PG8_ALIGN
#define PG8_ALIGN true
#endif

#ifndef MK_LATEW
#define MK_LATEW 1
#endif
#ifndef MK_XIT
#define MK_XIT 0
#endif
#ifndef MK_XM5
#define MK_XM5 0
#endif
constexpr int NWAVES = 8;
#ifndef MK_N_LAUNCHES
#define MK_N_LAUNCHES 1
#endif
constexpr int N_LAUNCHES = MK_N_LAUNCHES;

constexpr int BATCH = 4, T = 4096, D = 1024, FF = 4096, PLE = 256;
constexpr int M = BATCH * T;
constexpr int CONVD = 512, RWD = 512, NH = 8, HD = 64, RANK_W = 64, RANK_A = 64, RANK_G = 160;
constexpr int CONV_COLS = 3 * CONVD;
constexpr int RW_COLS = 3 * RWD + RANK_W + RANK_A + RANK_G;
constexpr int IN_COLS = CONV_COLS + RW_COLS;
constexpr int IN_PAD = 3584;
constexpr int PROJ_LD = IN_COLS;
constexpr int C_R = CONV_COLS, C_K = CONV_COLS + RWD, C_V = CONV_COLS + 2 * RWD, C_XW = CONV_COLS + 3 * RWD, C_XA = C_XW + RANK_W, C_XG = C_XA + RANK_A;
constexpr float RMS_EPS = 1e-6f, GN_EPS = 64e-5f, L2_EPS = 1e-12f;
constexpr int CH = 64, NCH = T / CH;

constexpr size_t MiB = 1u << 20;
constexpr size_t WS_CTL = 0, CTL_ZERO_BYTES = 64 * 1024;
constexpr size_t WS_WIN = 1 * MiB, WS_WOUT = 8 * MiB, WS_WUP = 10 * MiB, WS_WDN = 18 * MiB, WS_WG = 26 * MiB, WS_WPLE = 28 * MiB;
constexpr size_t WS_WL = 28 * MiB + 512 * 1024, WS_AL = WS_WL + 64 * 1024, WS_GL = WS_AL + 64 * 1024;
constexpr size_t WS_SSQ1 = 29 * MiB, WS_SSQ2 = WS_SSQ1 + 256 * 1024, WS_SSQ3 = WS_SSQ2 + 256 * 1024;
constexpr size_t WS_CB = 30 * MiB;
constexpr size_t WS_PB = 31 * MiB;
constexpr size_t WS_ABUF = 39 * MiB;
constexpr size_t WS_PLE = 71 * MiB;
constexpr size_t WS_MIX = 103 * MiB;
constexpr size_t WS_PROJ = 135 * MiB;
constexpr size_t WS_HSQ = 128 * MiB;
constexpr size_t WS_SB = 240 * MiB;
constexpr size_t WS_END = 256 * MiB;
static_assert(WS_PROJ + (size_t)M * PROJ_LD * 2 <= WS_SB && WS_HSQ + (size_t)M * FF * 2 <= WS_END && WS_GL + 512 * 160 * 2 <= WS_SSQ1, "d_ws map");
constexpr int CW_BAR = 1024;

constexpr int SLOT = 9216, NSLOT = 16, MLD = 72;
constexpr int RING_BYTES = 131072;
constexpr int LDSCTL_OFF = SLOT * NSLOT;
constexpr int LDS_BYTES = LDSCTL_OFF + 1024 + 12288;

#define GAS __attribute__((address_space(1)))
#define LAS __attribute__((address_space(3)))
#define DI __device__ __forceinline__
typedef unsigned short bf16;
typedef unsigned v4u __attribute__((ext_vector_type(4)));
typedef unsigned v2u __attribute__((ext_vector_type(2)));
typedef float f32x4 __attribute__((ext_vector_type(4)));
typedef short bf16x8 __attribute__((ext_vector_type(8)));
typedef GAS unsigned gu32;
#define RLX_AGENT __ATOMIC_RELAXED, __HIP_MEMORY_SCOPE_AGENT
#define LDS_WAIT() asm volatile("s_waitcnt lgkmcnt(0)" ::: "memory")
#define VM_WAIT() asm volatile("s_waitcnt vmcnt(0)" ::: "memory")
DI unsigned f2bf(float f) { unsigned u = __builtin_bit_cast(unsigned, f); return (u + 0x7fffu + ((u >> 16) & 1u)) >> 16; }
typedef __bf16 hbf16x2 __attribute__((ext_vector_type(2)));
typedef float f32x2v __attribute__((ext_vector_type(2)));
DI unsigned pk2(float lo, float hi) { const f32x2v f = {lo, hi}; return __builtin_bit_cast(unsigned, __builtin_convertvector(f, hbf16x2)); }
DI float bflo(unsigned w) { return __uint_as_float(w << 16); }
DI float bfhi(unsigned w) { return __uint_as_float(w & 0xffff0000u); }
DI void unpack8(const v4u w, float (&o)[8]) { o[0] = bflo(w.x); o[1] = bfhi(w.x); o[2] = bflo(w.y); o[3] = bfhi(w.y); o[4] = bflo(w.z); o[5] = bfhi(w.z); o[6] = bflo(w.w); o[7] = bfhi(w.w); }
DI v4u pack8(const float (&v)[8]) { v4u w; w.x = pk2(v[0], v[1]); w.y = pk2(v[2], v[3]); w.z = pk2(v[4], v[5]); w.w = pk2(v[6], v[7]); return w; }
DI float sigmoidf_(float x) { return 1.0f / (1.0f + __expf(-x)); }
DI float red8(float v) { v += __shfl_xor(v, 1); v += __shfl_xor(v, 2); v += __shfl_xor(v, 4); return v; }


#define XB_TMO      128
#define XB_XCNT(j)  (256  + 64 * (j))
#define XB_XSUB(j)  (1280 + 64 * (j))
#define XB_XGEN(j)  (2304 + 64 * (j))
#define XB_TOP      3328
#define XB_TOPGEN   3392
#define XCD_BAR_WORDS 3456
#define XB_SPIN_CAP (1u << 18)

__device__ __forceinline__ unsigned xb_ld(unsigned* p)              { return __hip_atomic_load(p, __ATOMIC_RELAXED, __HIP_MEMORY_SCOPE_AGENT); }
__device__ __forceinline__ unsigned xb_add(unsigned* p, unsigned v) { return __hip_atomic_fetch_add(p, v, __ATOMIC_RELAXED, __HIP_MEMORY_SCOPE_AGENT); }
__device__ __forceinline__ unsigned xb_xcc_id() { return (unsigned)__builtin_amdgcn_s_getreg((3 << 11) | 20) & 0xFu; }
#define XB_SPIN(cond, bar) do { unsigned _sp = 0; while (cond) { __builtin_amdgcn_s_sleep(1); \
    if ((++_sp & 255u) == 0u) { if (xb_ld(&(bar)[XB_TMO])) break; if (_sp > XB_SPIN_CAP) { atomicAdd(&(bar)[XB_TMO], 1u); break; } } } } while (0)

struct XcdBarrier {
    unsigned* bar; unsigned x;
    volatile LAS unsigned* st;
};

__device__ __forceinline__ XcdBarrier xcd_barrier_post(unsigned* bar, volatile LAS unsigned* st) {
    XcdBarrier b; b.bar = bar; b.x = xb_xcc_id(); b.st = st;
    if (threadIdx.x == 0) (void)xb_add(&bar[XB_XCNT(b.x)], 1u);
    return b;
}
__device__ __forceinline__ void xcd_barrier_complete(unsigned* bar, unsigned x, unsigned& nloc, unsigned& nx) {
    const unsigned G = gridDim.x * gridDim.y * gridDim.z;
    unsigned sum, cnt, mine, sp = 0u;
    for (;;) {
        sum = 0u; cnt = 0u; mine = 0u;
#pragma unroll
        for (unsigned j = 0; j < 16; ++j) { const unsigned c = xb_ld(&bar[XB_XCNT(j)]); sum += c; cnt += (c > 0u) ? 1u : 0u; mine = (j == x) ? c : mine; }
        if (sum == G) break;
        __builtin_amdgcn_s_sleep(1);
        if ((++sp & 255u) == 0u) { if (xb_ld(&bar[XB_TMO])) break; if (sp > XB_SPIN_CAP) { atomicAdd(&bar[XB_TMO], 1u); break; } }
    }
    nloc = mine > 0u ? mine : 1u; nx = cnt > 0u ? cnt : 1u;
}

__device__ __forceinline__ void xcd_barrier(const XcdBarrier& b) {
    asm volatile("s_waitcnt vmcnt(0)" ::: "memory");
    __syncthreads();
    if (threadIdx.x == 0) {
        unsigned* bar = b.bar;
        __builtin_amdgcn_s_waitcnt(0);
        unsigned nloc = b.st[0], nx = b.st[1];
        if (nloc == 0u) { xcd_barrier_complete(bar, b.x, nloc, nx); b.st[0] = nloc; b.st[1] = nx; }
        const unsigned old = xb_add(&bar[XB_XSUB(b.x)], 1u);
        const unsigned gen = old / nloc;
        if (old + 1u == (gen + 1u) * nloc) {
            __builtin_amdgcn_fence(__ATOMIC_RELEASE, "agent");
            asm volatile("s_waitcnt vmcnt(0)" ::: "memory");
            const unsigned og = xb_add(&bar[XB_TOP], 1u);
            const unsigned tg = og / nx;
            if (og + 1u == (tg + 1u) * nx) xb_add(&bar[XB_TOPGEN], 1u);
            else XB_SPIN(xb_ld(&bar[XB_TOPGEN]) == tg, bar);
            __builtin_amdgcn_fence(__ATOMIC_ACQUIRE, "agent");
            xb_add(&bar[XB_XGEN(b.x)], 1u);
            asm volatile("s_waitcnt vmcnt(0)" ::: "memory");
        } else {
            XB_SPIN(xb_ld(&bar[XB_XGEN(b.x)]) == gen, bar);
            __builtin_amdgcn_fence(__ATOMIC_ACQUIRE, "agent");
            asm volatile("s_waitcnt vmcnt(0)" ::: "memory");
        }
    }
    __syncthreads();
}


struct Frame {
    LAS unsigned char* lds;
    volatile LAS unsigned* MISC;
    gu32* ctl;
    int tid, lane, wave;
    int vcu, G;
    unsigned char* ws;
    const float *x, *p, *norm_mix_g, *w_in, *conv_w, *shift_mu, *w_lora_up, *w0, *a_lora_up, *a0, *g_lora_up, *k_k, *k_a, *r_k, *ln_x_g, *ln_x_b, *w_out, *norm_mlp_g, *w_up, *w_down, *norm_ple_g, *w_ple_gate, *w_ple_proj, *norm_final_g;
    float* out;
};
DI float wave_sum(float v) {
#pragma unroll
    for (int o = 1; o < 64; o <<= 1) v += __shfl_xor(v, o);
    return v;
}
DI void p0_transpose_item(const float* W, int K, int N, bf16* WT, int row_off, const float* gk, LAS float* scr, int item, int lane) {
    const int nblk = N / 32, kb = item / nblk, nb = item % nblk, k0 = 64 * kb, n0 = 32 * nb;
#pragma unroll 8
    for (int i = 0; i < 32; ++i) { const int kk = 2 * i + (lane >> 5); float v = W[(size_t)(k0 + kk) * N + n0 + (lane & 31)]; if (gk) v *= gk[k0 + kk]; scr[kk * 33 + (lane & 31)] = v; }
    LDS_WAIT(); asm volatile("" ::: "memory");
    const int c = lane & 7;
#pragma unroll
    for (int j = 0; j < 4; ++j) { const int n = (lane >> 3) + 8 * j; const LAS float* s = scr + (8 * c) * 33 + n;
        v4u o; o.x = pk2(s[0 * 33], s[1 * 33]); o.y = pk2(s[2 * 33], s[3 * 33]); o.z = pk2(s[4 * 33], s[5 * 33]); o.w = pk2(s[6 * 33], s[7 * 33]);
        *(GAS v4u*)(WT + (size_t)(row_off + n0 + n) * K + k0 + 8 * c) = o; }
    LDS_WAIT(); asm volatile("" ::: "memory");
}
DI void rms_row_to_bf16(Frame& F, const float* xrow, const float* g, bf16* orow) {
    const GAS f32x4* xr = (const GAS f32x4*)xrow + F.lane; const GAS f32x4* gr = (const GAS f32x4*)g + F.lane;
    f32x4 v[4]; float s = 0.f;
#pragma unroll
    for (int j = 0; j < 4; ++j) { v[j] = xr[64 * j]; s += (v[j].x * v[j].x + v[j].y * v[j].y) + (v[j].z * v[j].z + v[j].w * v[j].w); }
    const float rstd = rsqrtf(wave_sum(s) * (1.f / D) + RMS_EPS);
    GAS unsigned long long* o8 = (GAS unsigned long long*)orow + F.lane;
#pragma unroll
    for (int j = 0; j < 4; ++j) { const f32x4 gg = gr[64 * j]; o8[64 * j] = (unsigned long long)pk2(v[j].x * rstd * gg.x, v[j].y * rstd * gg.y) | ((unsigned long long)pk2(v[j].z * rstd * gg.z, v[j].w * rstd * gg.w) << 32); }
}
DI void convert_weights(Frame& F, int part, LAS float* scr, int gw, int NGW) {
    bf16* WIN = (bf16*)(F.ws + WS_WIN); bf16* WOUT = (bf16*)(F.ws + WS_WOUT); bf16* WUP = (bf16*)(F.ws + WS_WUP); bf16* WDN = (bf16*)(F.ws + WS_WDN); bf16* WG = (bf16*)(F.ws + WS_WG); bf16* WPLE = (bf16*)(F.ws + WS_WPLE);
    bf16* WL = (bf16*)(F.ws + WS_WL); bf16* AL = (bf16*)(F.ws + WS_AL);
    constexpr int I_IN = (D / 64) * (IN_COLS / 32), I_OUT = (D / 64) * (D / 32), I_UP = (D / 64) * (FF / 32), I_DN = (FF / 64) * (D / 32), I_G = I_OUT, I_PLE = (PLE / 64) * (D / 32), I_WL = (RANK_W / 64) * (RWD / 32), I_AL = I_WL;
    if (part == 0) {
        constexpr int NITEMS = I_IN + I_PLE + I_WL + I_AL;
        for (int it = gw; it < NITEMS; it += NGW) {
            int r = it;
            if (r < I_IN) { p0_transpose_item(F.w_in, D, IN_COLS, WIN, 0, nullptr, scr, r, F.lane); continue; } r -= I_IN;
            if (r < I_PLE) { p0_transpose_item(F.w_ple_proj, PLE, D, WPLE, 0, nullptr, scr, r, F.lane); continue; } r -= I_PLE;
            if (r < I_WL) { p0_transpose_item(F.w_lora_up, RANK_W, RWD, WL, 0, nullptr, scr, r, F.lane); continue; } r -= I_WL;
            p0_transpose_item(F.a_lora_up, RANK_A, RWD, AL, 0, nullptr, scr, r, F.lane);
        }
    } else {
        constexpr int NITEMS = I_OUT + I_UP + I_DN + I_G;
        for (int it = gw; it < NITEMS; it += NGW) {
            int r = it;
            if (r < I_OUT) { p0_transpose_item(F.w_out, D, D, WOUT, 0, nullptr, scr, r, F.lane); continue; } r -= I_OUT;
            if (r < I_UP) { p0_transpose_item(F.w_up, D, FF, WUP, 0, F.norm_mlp_g, scr, r, F.lane); continue; } r -= I_UP;
            if (r < I_DN) { p0_transpose_item(F.w_down, FF, D, WDN, 0, nullptr, scr, r, F.lane); continue; } r -= I_DN;
            p0_transpose_item(F.w_ple_gate, D, D, WG, 0, F.norm_ple_g, scr, r, F.lane);
        }
    }
}
DI void p0_prologue(Frame& F) {
    LAS float* scr = (LAS float*)(F.lds + F.wave * 16384);
    const int gw = F.vcu * NWAVES + F.wave, NGW = F.G * NWAVES;
    bf16* WIN = (bf16*)(F.ws + WS_WIN); bf16* GL = (bf16*)(F.ws + WS_GL);
    convert_weights(F, 0, scr, gw, NGW);
    if (MK_LATEW == 0) convert_weights(F, 1, scr, gw, NGW);
    const int gt = F.vcu * (NWAVES * 64) + F.tid, NGT = F.G * NWAVES * 64;
    for (int i = gt; i < (IN_PAD - IN_COLS) * D / 8; i += NGT) ((GAS v4u*)(WIN + (size_t)IN_COLS * D))[i] = (v4u){0u, 0u, 0u, 0u};
    for (int i = gt; i < RWD * RANK_G; i += NGT) { const int n = i / RANK_G, rho = i % RANK_G; GL[i] = (bf16)f2bf(F.g_lora_up[(size_t)rho * RWD + n]); }
    bf16* XN = (bf16*)(F.ws + WS_ABUF); bf16* PB = (bf16*)(F.ws + WS_PB);
    for (int m = gw; m < M; m += NGW) {
        rms_row_to_bf16(F, F.x + (size_t)m * D, F.norm_mix_g, XN + (size_t)m * D);
        const f32x4 pv = ((const GAS f32x4*)(F.p + (size_t)m * PLE))[F.lane];
        ((GAS unsigned long long*)(PB + (size_t)m * PLE))[F.lane] = (unsigned long long)pk2(pv.x, pv.y) | ((unsigned long long)pk2(pv.z, pv.w) << 32);
    }
}
DI void final_norm(Frame& F) {
    const int gw = F.vcu * NWAVES + F.wave, NGW = F.G * NWAVES;
    const float* ssq = (const float*)(F.ws + WS_SSQ3);
    const GAS f32x4* gr = (const GAS f32x4*)F.norm_final_g + F.lane;
    f32x4 gg[4];
#pragma unroll
    for (int j = 0; j < 4; ++j) gg[j] = gr[64 * j];
    for (int m = gw; m < M; m += NGW) {
        const f32x4 s4 = *(const GAS f32x4*)(ssq + (size_t)m * 4); const float rstd = rsqrtf(((s4[0] + s4[1]) + (s4[2] + s4[3])) * (1.f / D) + RMS_EPS);
        GAS f32x4* xr = (GAS f32x4*)(F.out + (size_t)m * D) + F.lane;
#pragma unroll
        for (int j = 0; j < 4; ++j) { f32x4 v = xr[64 * j]; v = v * rstd * gg[j]; xr[64 * j] = v; }
    }
}

#define MFMA16(a, b, c) __builtin_amdgcn_mfma_f32_16x16x32_bf16((a), (b), (c), 0, 0, 0)
typedef float f32x16 __attribute__((ext_vector_type(16)));
#define MFMA32(a, b, c) __builtin_amdgcn_mfma_f32_32x32x16_bf16((a), (b), (c), 0, 0, 0)
DI void load_shift8(const bf16* proj, size_t row, bool has_prev, int col, const float* shift_mu, float (&o)[8]) {
    const v4u c = *(const GAS v4u*)(proj + row * PROJ_LD + col);
    v4u p = *(const GAS v4u*)(proj + (row - (has_prev ? 1 : 0)) * PROJ_LD + col); if (!has_prev) p = (v4u){0u, 0u, 0u, 0u};
    const f32x4 m0 = *(const GAS f32x4*)(shift_mu + (col - CONV_COLS)), m1 = *(const GAS f32x4*)(shift_mu + (col - CONV_COLS) + 4);
    float cu[8], pr[8]; unpack8(c, cu); unpack8(p, pr);
    const float mu[8] = {m0[0], m0[1], m0[2], m0[3], m1[0], m1[1], m1[2], m1[3]};
#pragma unroll
    for (int j = 0; j < 8; ++j) o[j] = cu[j] + mu[j] * (pr[j] - cu[j]);
}
DI void ld8f(const float* g, float (&o)[8]) { const f32x4 a = *(const GAS f32x4*)g, b = *(const GAS f32x4*)(g + 4); o[0] = a[0]; o[1] = a[1]; o[2] = a[2]; o[3] = a[3]; o[4] = b[0]; o[5] = b[1]; o[6] = b[2]; o[7] = b[3]; }
DI void lds_ld8f(const LAS float* g, float (&o)[8]) { const f32x4 a = *(const LAS f32x4*)g, b = *(const LAS f32x4*)(g + 4); o[0] = a[0]; o[1] = a[1]; o[2] = a[2]; o[3] = a[3]; o[4] = b[0]; o[5] = b[1]; o[6] = b[2]; o[7] = b[3]; }
DI void lds_st8f(LAS float* g, const float (&v)[8]) { *(LAS f32x4*)g = (f32x4){v[0], v[1], v[2], v[3]}; *(LAS f32x4*)(g + 4) = (f32x4){v[4], v[5], v[6], v[7]}; }
template <int KS> DI void mm_ll(f32x4& acc, const LAS bf16* A, int lda, const LAS bf16* Bt, int ldb, int mt, int nt, int fr, int fq) {
#pragma unroll
    for (int s = 0; s < KS; ++s) { const bf16x8 a = *(const LAS bf16x8*)(A + (mt * 16 + fr) * lda + s * 32 + fq * 8); const bf16x8 b = *(const LAS bf16x8*)(Bt + (nt * 16 + fr) * ldb + s * 32 + fq * 8);
        acc = MFMA16(b, a, acc); }
}
template <int KS> DI void mm_lg(f32x4& acc, const LAS bf16* A, int lda, const bf16* Bt, int ldb, int mt, int nt, int fr, int fq) {
#pragma unroll
    for (int s = 0; s < KS; ++s) { const bf16x8 a = *(const LAS bf16x8*)(A + (mt * 16 + fr) * lda + s * 32 + fq * 8); const bf16x8 b = *(const GAS bf16x8*)(Bt + (size_t)(nt * 16 + fr) * ldb + s * 32 + fq * 8);
        acc = MFMA16(b, a, acc); }
}

DI void rw_prep1(Frame& F, const bf16* proj, int b, int h, int c, LAS bf16* XW, LAS bf16* XA, float (&r8)[8], float (&k8)[8], float (&v8)[8]) {
    const int t = F.tid >> 3, cg = F.tid & 7, tau = c * CH + t; const size_t row = (size_t)b * T + tau; const bool hp = tau > 0;
    load_shift8(proj, row, hp, C_R + h * HD + cg * 8, F.shift_mu, r8);
    load_shift8(proj, row, hp, C_K + h * HD + cg * 8, F.shift_mu, k8);
    load_shift8(proj, row, hp, C_V + h * HD + cg * 8, F.shift_mu, v8);
    float xw[8], xa[8];
    load_shift8(proj, row, hp, C_XW + cg * 8, F.shift_mu, xw);
    load_shift8(proj, row, hp, C_XA + cg * 8, F.shift_mu, xa);
#pragma unroll
    for (int j = 0; j < 8; ++j) xw[j] = tanhf(xw[j]);
    *(LAS v4u*)(XW + t * MLD + cg * 8) = pack8(xw);
    *(LAS v4u*)(XA + t * MLD + cg * 8) = pack8(xa);
}
DI void rw_lora(Frame& F, int h, const LAS bf16* XW, const LAS bf16* XA, LAS float* LW, LAS float* IC) {
    const int mt = F.wave >> 1, nt0 = (F.wave & 1) * 2, fr = F.lane & 15, fq = F.lane >> 4;
    const bf16* WL = (const bf16*)(F.ws + WS_WL) + (size_t)h * HD * RANK_W; const bf16* AL = (const bf16*)(F.ws + WS_AL) + (size_t)h * HD * RANK_A;
#pragma unroll
    for (int q = 0; q < 2; ++q) { const int nt = nt0 + q; const int n0 = nt * 16 + 4 * fq;
        f32x4 aw = (f32x4){0.f, 0.f, 0.f, 0.f}, aa = aw;
        mm_lg<2>(aw, XW, MLD, WL, RANK_W, mt, nt, fr, fq);
        mm_lg<2>(aa, XA, MLD, AL, RANK_A, mt, nt, fr, fq);
        const f32x4 w0v = *(const GAS f32x4*)(F.w0 + h * HD + n0), a0v = *(const GAS f32x4*)(F.a0 + h * HD + n0);
        f32x4 lw, ic;
#pragma unroll
        for (int i = 0; i < 4; ++i) { const float z = aw[i] + w0v[i]; const float xs = -z; const float sp = fmaxf(xs, 0.f) + log1pf(expf(-fabsf(xs))); lw[i] = -expf(-sp - 0.5f); ic[i] = sigmoidf_(aa[i] + a0v[i]); }
        *(LAS f32x4*)(LW + (mt * 16 + fr) * 64 + n0) = lw; *(LAS f32x4*)(IC + (mt * 16 + fr) * 64 + n0) = ic; }
}
constexpr int GLD = 168;
DI void rw_gate_prep(Frame& F, const bf16* proj, int b, int c, LAS bf16* XG) {
    const int t = F.tid >> 3, cg = F.tid & 7, tau = c * CH + t; const size_t row = (size_t)b * T + tau; const bool hp = tau > 0;
#pragma unroll
    for (int q = 0; q < 3; ++q) { const int g8 = cg + 8 * q; if (g8 < RANK_G / 8) { float xg[8]; load_shift8(proj, row, hp, C_XG + g8 * 8, F.shift_mu, xg);
#pragma unroll
        for (int j = 0; j < 8; ++j) xg[j] = sigmoidf_(xg[j]);
        *(LAS v4u*)(XG + t * GLD + g8 * 8) = pack8(xg); } }
}
DI void rw_gate_mm(Frame& F, int h, const LAS bf16* XG, LAS float* Gm) {
    const int mt = F.wave >> 1, nt0 = (F.wave & 1) * 2, fr = F.lane & 15, fq = F.lane >> 4;
    const bf16* GL = (const bf16*)(F.ws + WS_GL) + (size_t)h * HD * RANK_G;
#pragma unroll
    for (int q = 0; q < 2; ++q) { const int nt = nt0 + q; f32x4 ag = (f32x4){0.f, 0.f, 0.f, 0.f};
        mm_lg<5>(ag, XG, GLD, GL, RANK_G, mt, nt, fr, fq);
        *(LAS f32x4*)(Gm + (mt * 16 + fr) * 64 + nt * 16 + 4 * fq) = ag; }
}
DI void rw_out_epi(Frame& F, int b, int h, int c, const float (&y8)[8], const float (&v8)[8], float cb, const float (&g8)[8]) {
    const int t = F.tid >> 3, cg = F.tid & 7; const size_t row = (size_t)b * T + c * CH + t;
    float s = 0.f;
#pragma unroll
    for (int j = 0; j < 8; ++j) s += y8[j];
    const float mean = red8(s) * (1.f / 64.f); float q = 0.f;
#pragma unroll
    for (int j = 0; j < 8; ++j) { const float d = y8[j] - mean; q += d * d; }
    const float rstd = rsqrtf(red8(q) * (1.f / 64.f) + GN_EPS);
    float lg[8], lb[8], o[8]; ld8f(F.ln_x_g + h * HD + cg * 8, lg); ld8f(F.ln_x_b + h * HD + cg * 8, lb);
#pragma unroll
    for (int j = 0; j < 8; ++j) o[j] = ((y8[j] - mean) * rstd * lg[j] + lb[j] + cb * v8[j]) * g8[j];
    bf16* mix = (bf16*)(F.ws + WS_MIX);
    *(GAS v4u*)(mix + row * D + CONVD + h * HD + cg * 8) = pack8(o);
}
DI void conv_wave(Frame& F, int cw, int nw) {
    const bf16* proj = (const bf16*)(F.ws + WS_PROJ); bf16* mix = (bf16*)(F.ws + WS_MIX);
    const int ch = F.lane * 8;
    float w0[8], w1[8], w2[8]; ld8f(F.conv_w + ch, w0); ld8f(F.conv_w + CONVD + ch, w1); ld8f(F.conv_w + 2 * CONVD + ch, w2);
    for (int m = cw; m < M; m += nw) {
        const int tau = m % T; const bf16* pr = proj + (size_t)m * PROJ_LD;
        const int d1 = tau >= 1 ? 1 : 0, d2 = tau >= 2 ? 2 : 0;
        const v4u gbw = *(const GAS v4u*)(pr + ch), c2 = *(const GAS v4u*)(pr + CONVD + ch), h2 = *(const GAS v4u*)(pr + 2 * CONVD + ch);
        const v4u c1 = *(const GAS v4u*)(pr - d1 * PROJ_LD + CONVD + ch), h1 = *(const GAS v4u*)(pr - d1 * PROJ_LD + 2 * CONVD + ch);
        const v4u c0 = *(const GAS v4u*)(pr - d2 * PROJ_LD + CONVD + ch), h0 = *(const GAS v4u*)(pr - d2 * PROJ_LD + 2 * CONVD + ch);
        float gb[8], gc[8], hx[8], o[8], u[8];
        unpack8(gbw, gb);
        unpack8(c2, gc); unpack8(h2, hx);
#pragma unroll
        for (int j = 0; j < 8; ++j) o[j] = gc[j] * hx[j] * w2[j];
        unpack8(c1, gc); unpack8(h1, hx);
#pragma unroll
        for (int j = 0; j < 8; ++j) { u[j] = (tau >= 1) ? gc[j] * hx[j] : 0.f; o[j] += u[j] * w1[j]; }
        unpack8(c0, gc); unpack8(h0, hx);
#pragma unroll
        for (int j = 0; j < 8; ++j) { u[j] = (tau >= 2) ? gc[j] * hx[j] : 0.f; o[j] = gb[j] * (o[j] + u[j] * w0[j]); }
        *(GAS v4u*)(mix + (size_t)m * D + ch) = pack8(o);
    }
}
#ifndef MK_NAIVE
#define MK_NAIVE 0
#endif
#if MK_NAIVE
DI void rwkv_naive_chain(Frame& F, int chain) {
    const int b = chain / NH, h = chain % NH;
    const bf16* proj = (const bf16*)(F.ws + WS_PROJ);
    LAS float* F0 = (LAS float*)(F.lds);
    LAS float* F1 = F0 + 4096;
    LAS float* FR = F0 + 2 * 4096; LAS float* FK = F0 + 3 * 4096; LAS float* FV = F0 + 4 * 4096; LAS float* FA = F0 + 5 * 4096; LAS float* FB = F0 + 6 * 4096;
    LAS bf16* XW = (LAS bf16*)(F.lds + 7 * 16384); LAS bf16* XA = XW + 64 * MLD;
    LAS bf16* XG = (LAS bf16*)FA;
    LAS float* Gm = FR;
    const int t = F.tid >> 3, cg = F.tid & 7;
    float S[8];
#pragma unroll
    for (int j = 0; j < 8; ++j) S[j] = 0.f;
    float kkw[8], kaw[8], rkw[8]; ld8f(F.k_k + h * HD + cg * 8, kkw); ld8f(F.k_a + h * HD + cg * 8, kaw); ld8f(F.r_k + h * HD + cg * 8, rkw);
    for (int c = 0; c < NCH; ++c) {
        float r8[8], k8[8], v8[8];
        rw_prep1(F, proj, b, h, c, XW, XA, r8, k8, v8);
        LDS_WAIT(); __syncthreads();
        rw_lora(F, h, XW, XA, F0, F1);
        LDS_WAIT(); __syncthreads();
        float lw[8], ic[8]; lds_ld8f(F0 + t * 64 + cg * 8, lw); lds_ld8f(F1 + t * 64 + cg * 8, ic);
        float kk[8], ss = 0.f;
#pragma unroll
        for (int j = 0; j < 8; ++j) { kk[j] = k8[j] * kkw[j]; ss += kk[j] * kk[j]; }
        const float inv = 1.0f / fmaxf(sqrtf(red8(ss)), L2_EPS);
        float kh[8], a8[8], b8[8], w8[8], cbp = 0.f;
#pragma unroll
        for (int j = 0; j < 8; ++j) { const float kn = kk[j] * inv; kh[j] = k8[j] * (1.0f + (ic[j] - 1.0f) * kaw[j]); a8[j] = -kn; b8[j] = kn * ic[j]; w8[j] = expf(lw[j]); cbp += r8[j] * kh[j] * rkw[j]; }
        const float cb = red8(cbp);
        __syncthreads();
        lds_st8f(F0 + t * 64 + cg * 8, w8); lds_st8f(FR + t * 64 + cg * 8, r8); lds_st8f(FK + t * 64 + cg * 8, kh); lds_st8f(FV + t * 64 + cg * 8, v8); lds_st8f(FA + t * 64 + cg * 8, a8); lds_st8f(FB + t * 64 + cg * 8, b8);
        LDS_WAIT(); __syncthreads();
        for (int s = 0; s < CH; ++s) {
            float aa[8], bb[8], ww[8], kx[8], rr[8];
            lds_ld8f(FA + s * 64 + cg * 8, aa); lds_ld8f(FB + s * 64 + cg * 8, bb); lds_ld8f(F0 + s * 64 + cg * 8, ww); lds_ld8f(FK + s * 64 + cg * 8, kx); lds_ld8f(FR + s * 64 + cg * 8, rr);
            const float vi = FV[s * 64 + t];
            float sa = 0.f;
#pragma unroll
            for (int j = 0; j < 8; ++j) sa += S[j] * aa[j];
            sa = red8(sa);
            float y = 0.f;
#pragma unroll
            for (int j = 0; j < 8; ++j) { S[j] = S[j] * ww[j] + sa * bb[j] + vi * kx[j]; y += S[j] * rr[j]; }
            y = red8(y);
            if (cg == 0) F1[s * 64 + t] = y;
        }
        LDS_WAIT(); __syncthreads();
        rw_gate_prep(F, proj, b, c, XG);
        LDS_WAIT(); __syncthreads();
        rw_gate_mm(F, h, XG, Gm);
        LDS_WAIT(); __syncthreads();
        float y8[8], g8[8]; lds_ld8f(F1 + t * 64 + cg * 8, y8); lds_ld8f(Gm + t * 64 + cg * 8, g8);
        rw_out_epi(F, b, h, c, y8, v8, cb, g8);
        __syncthreads();
    }
}

#endif
DI LAS bf16* slotp(Frame& F, int i) { return (LAS bf16*)(F.lds + i * SLOT); }
DI void st_n(LAS bf16* Dst, int mt, int nt, int fr, int fq, const f32x4 v) { v2u w; w.x = pk2(v[0], v[1]); w.y = pk2(v[2], v[3]); *(LAS v2u*)(Dst + (mt * 16 + fr) * MLD + nt * 16 + 4 * fq) = w; }
DI void st_t(LAS bf16* Dst, int mt, int nt, int fr, int fq, const f32x4 v) {
#pragma unroll
    for (int i = 0; i < 4; ++i) Dst[(nt * 16 + 4 * fq + i) * MLD + mt * 16 + fr] = (bf16)f2bf(v[i]); }
DI f32x4 ld_tile(const LAS bf16* Src, int mt, int nt, int fr, int fq) { const v2u w = *(const LAS v2u*)(Src + (mt * 16 + fr) * MLD + nt * 16 + 4 * fq); return (f32x4){bflo(w.x), bfhi(w.x), bflo(w.y), bfhi(w.y)}; }
DI void st_g(bf16* Dst, int mt, int nt, int fr, int fq, const f32x4 v) { v2u w; w.x = pk2(v[0], v[1]); w.y = pk2(v[2], v[3]); *(GAS v2u*)(Dst + (mt * 16 + fr) * 64 + nt * 16 + 4 * fq) = w; }
DI f32x4 ld_g(const bf16* Src, int mt, int nt, int fr, int fq) { const v2u w = *(const GAS v2u*)(Src + (mt * 16 + fr) * 64 + nt * 16 + 4 * fq); return (f32x4){bflo(w.x), bfhi(w.x), bflo(w.y), bfhi(w.y)}; }
template <int KS> DI void mm_gg(f32x4& acc, const bf16* A, int lda, const bf16* Bt, int ldb, int mt, int nt, int fr, int fq) {
#pragma unroll
    for (int s = 0; s < KS; ++s) { const bf16x8 a = *(const GAS bf16x8*)(A + (size_t)(mt * 16 + fr) * lda + s * 32 + fq * 8); const bf16x8 b = *(const GAS bf16x8*)(Bt + (size_t)(nt * 16 + fr) * ldb + s * 32 + fq * 8);
        acc = MFMA16(b, a, acc); }
}
constexpr size_t CHUNK_ELEMS = 64 * 64, NCHUNKS = (size_t)BATCH * NH * NCH;
DI bf16* chunk_PT(Frame& F) { return (bf16*)F.out; }
DI bf16* chunk_Q(Frame& F) { return (bf16*)F.out + NCHUNKS * CHUNK_ELEMS; }
DI bf16* chunk_RW(Frame& F) { return (bf16*)F.out + 2 * NCHUNKS * CHUNK_ELEMS; }
DI bf16* chunk_YP(Frame& F) { return (bf16*)F.out + 3 * NCHUNKS * CHUNK_ELEMS; }
#define BAR() do { LDS_WAIT(); __syncthreads(); } while (0)

DI void rw_chunk_item(Frame& F, int b, int h, int c) {
    const bf16* proj = (const bf16*)(F.ws + WS_PROJ);
    const size_t ci = ((size_t)(b * NH + h) * NCH + c) * CHUNK_ELEMS;
    const int t = F.tid >> 3, cg = F.tid & 7;
    const int mt = F.wave >> 1, nt0 = (F.wave & 1) * 2, fr = F.lane & 15, fq = F.lane >> 4;
    LAS bf16* XW = slotp(F, 0); LAS bf16* XA = slotp(F, 1); LAS float* LW = (LAS float*)slotp(F, 2); LAS float* IC = (LAS float*)slotp(F, 4); LAS float* SEG = (LAS float*)slotp(F, 14);
    LAS float* GC = (LAS float*)(F.lds + LDSCTL_OFF + 512);
    LAS bf16* sAt = slotp(F, 6); LAS bf16* sAtT = slotp(F, 7); LAS bf16* sRt = slotp(F, 8); LAS bf16* sBt = slotp(F, 9); LAS bf16* sKt = slotp(F, 10); LAS bf16* sBhT = slotp(F, 11); LAS bf16* sKhT = slotp(F, 12); LAS bf16* sVt = slotp(F, 13);
    float r8[8], k8[8], v8[8];
    rw_prep1(F, proj, b, h, c, XW, XA, r8, k8, v8);
    BAR();
    rw_lora(F, h, XW, XA, LW, IC);
    BAR();
    {
        const int seg = F.wave, kc = F.lane; float pfx[8]; float run = 0.f;
#pragma unroll
        for (int j = 0; j < 8; ++j) { run += LW[(seg * 8 + j) * 64 + kc]; pfx[j] = run; }
        SEG[seg * 64 + kc] = run;
        BAR();
        float off = 0.f;
#pragma unroll
        for (int s = 0; s < 8; ++s) { const float sv = SEG[s * 64 + kc]; off += (s < seg) ? sv : 0.f; }
#pragma unroll
        for (int j = 0; j < 8; ++j) LW[(seg * 8 + j) * 64 + kc] = pfx[j] + off;
        BAR();
    }
    {
        float Lt[8], Lm[8], LC[8], ic[8];
        lds_ld8f(LW + t * 64 + cg * 8, Lt); lds_ld8f(LW + 63 * 64 + cg * 8, LC); lds_ld8f(IC + t * 64 + cg * 8, ic);
        if (t > 0) lds_ld8f(LW + (t - 1) * 64 + cg * 8, Lm); else {
#pragma unroll
            for (int j = 0; j < 8; ++j) Lm[j] = 0.f; }
        float kkw[8], kaw[8], rkw[8]; ld8f(F.k_k + h * HD + cg * 8, kkw); ld8f(F.k_a + h * HD + cg * 8, kaw); ld8f(F.r_k + h * HD + cg * 8, rkw);
        float kk[8], ss = 0.f;
#pragma unroll
        for (int j = 0; j < 8; ++j) { kk[j] = k8[j] * kkw[j]; ss += kk[j] * kk[j]; }
        const float inv = 1.0f / fmaxf(sqrtf(red8(ss)), L2_EPS);
        float at[8], rt[8], bt[8], kt[8], bh[8], khh[8], cbp = 0.f;
#pragma unroll
        for (int j = 0; j < 8; ++j) { const float kn = kk[j] * inv; const float kh = k8[j] * (1.0f + (ic[j] - 1.0f) * kaw[j]); const float bb = kn * ic[j];
            const float em = expf(Lm[j]), et = expf(Lt[j]), en = expf(-Lt[j]), ec = expf(LC[j] - Lt[j]);
            at[j] = -kn * em; rt[j] = r8[j] * et; bt[j] = bb * en; kt[j] = kh * en; bh[j] = bb * ec; khh[j] = kh * ec; cbp += r8[j] * kh * rkw[j]; }
        const float cb = red8(cbp);
        if (cg == 0) ((float*)(F.ws + WS_CB))[((size_t)b * T + c * CH + t) * NH + h] = cb;
        if (t == 63) {
#pragma unroll
            for (int j = 0; j < 8; ++j) GC[cg * 8 + j] = expf(LC[j]); }
        *(LAS v4u*)(sAt + t * MLD + cg * 8) = pack8(at); *(LAS v4u*)(sRt + t * MLD + cg * 8) = pack8(rt); *(LAS v4u*)(sBt + t * MLD + cg * 8) = pack8(bt); *(LAS v4u*)(sKt + t * MLD + cg * 8) = pack8(kt);
#pragma unroll
        for (int j = 0; j < 8; ++j) { const int kc = cg * 8 + j; sAtT[kc * MLD + t] = (bf16)f2bf(at[j]); sBhT[kc * MLD + t] = (bf16)f2bf(bh[j]); sKhT[kc * MLD + t] = (bf16)f2bf(khh[j]); sVt[kc * MLD + t] = (bf16)f2bf(v8[j]); }
    }
    BAR();
    LAS bf16* sN = slotp(F, 0); LAS bf16* sNT = slotp(F, 1); LAS bf16* sT0 = slotp(F, 2); LAS bf16* sAak = slotp(F, 3); LAS bf16* sArb = slotp(F, 4); LAS bf16* sArk = slotp(F, 5);
#pragma unroll
    for (int q = 0; q < 2; ++q) { const int nt = nt0 + q; const f32x4 z = (f32x4){0.f, 0.f, 0.f, 0.f};
        f32x4 ab = z, ak = z, rb = z, rk = z;
        if (nt <= mt) { mm_ll<2>(ab, sAt, MLD, sBt, MLD, mt, nt, fr, fq); mm_ll<2>(ak, sAt, MLD, sKt, MLD, mt, nt, fr, fq); mm_ll<2>(rb, sRt, MLD, sBt, MLD, mt, nt, fr, fq); mm_ll<2>(rk, sRt, MLD, sKt, MLD, mt, nt, fr, fq); }
        const int m = mt * 16 + fr; f32x4 t0;
#pragma unroll
        for (int i = 0; i < 4; ++i) { const int n = nt * 16 + 4 * fq + i; if (!(n < m)) { ab[i] = 0.f; ak[i] = 0.f; } if (!(n <= m)) { rb[i] = 0.f; rk[i] = 0.f; } t0[i] = ab[i] + ((n == m) ? 1.0f : 0.f); }
        st_n(sN, mt, nt, fr, fq, ab); st_t(sNT, mt, nt, fr, fq, ab); st_n(sT0, mt, nt, fr, fq, t0); st_n(sAak, mt, nt, fr, fq, ak); st_n(sArb, mt, nt, fr, fq, rb); st_n(sArk, mt, nt, fr, fq, rk); }
    BAR();
    LAS bf16* sM1T = slotp(F, 9);
#pragma unroll
    for (int q = 0; q < 2; ++q) { const int nt = nt0 + q; f32x4 n2 = (f32x4){0.f, 0.f, 0.f, 0.f}, m1 = n2;
        mm_ll<2>(n2, sN, MLD, sNT, MLD, mt, nt, fr, fq); mm_ll<2>(m1, sAak, MLD, sVt, MLD, mt, nt, fr, fq);
        st_n(slotp(F, 15), mt, nt, fr, fq, n2); st_t(slotp(F, 6), mt, nt, fr, fq, n2); st_t(sM1T, mt, nt, fr, fq, m1); }
    BAR();
    for (int it = 1; it <= 5; ++it) {
        const bool odd = it & 1;
        const LAS bf16* cT = slotp(F, odd ? 2 : 14); const LAS bf16* cNp = slotp(F, odd ? 15 : 0); const LAS bf16* cNpT = slotp(F, odd ? 6 : 1);
        LAS bf16* dT = slotp(F, odd ? 14 : 2); LAS bf16* dNp = slotp(F, odd ? 0 : 15); LAS bf16* dNpT = slotp(F, odd ? 1 : 6);
#pragma unroll
        for (int q = 0; q < 2; ++q) { const int nt = nt0 + q; f32x4 tn = ld_tile(cT, mt, nt, fr, fq);
            mm_ll<2>(tn, cT, MLD, cNpT, MLD, mt, nt, fr, fq); st_n(dT, mt, nt, fr, fq, tn);
            if (it < 5) { f32x4 n2 = (f32x4){0.f, 0.f, 0.f, 0.f}; mm_ll<2>(n2, cNp, MLD, cNpT, MLD, mt, nt, fr, fq); st_n(dNp, mt, nt, fr, fq, n2); st_t(dNpT, mt, nt, fr, fq, n2); } }
        BAR();
    }
    LAS bf16* sTm = slotp(F, 14); LAS bf16* sWT = slotp(F, 0); LAS bf16* sUT = slotp(F, 1);
#pragma unroll
    for (int q = 0; q < 2; ++q) { const int nt = nt0 + q; f32x4 w = (f32x4){0.f, 0.f, 0.f, 0.f}, u = w;
        mm_ll<2>(w, sTm, MLD, sAtT, MLD, mt, nt, fr, fq); mm_ll<2>(u, sTm, MLD, sM1T, MLD, mt, nt, fr, fq);
        st_t(sWT, mt, nt, fr, fq, w); st_t(sUT, mt, nt, fr, fq, u); }
    BAR();
    bf16* gPT = chunk_PT(F) + ci; bf16* gQ = chunk_Q(F) + ci; bf16* gRW = chunk_RW(F) + ci; bf16* gYP = chunk_YP(F) + ci;
#pragma unroll
    for (int q = 0; q < 2; ++q) { const int nt = nt0 + q; const f32x4 z = (f32x4){0.f, 0.f, 0.f, 0.f};
        f32x4 pt = z, qq = z, rw = ld_tile(sRt, mt, nt, fr, fq), yp = z;
        mm_ll<2>(pt, sBhT, MLD, sWT, MLD, mt, nt, fr, fq);
        const int m = mt * 16 + fr;
#pragma unroll
        for (int i = 0; i < 4; ++i) { const int n = nt * 16 + 4 * fq + i; if (n == m) pt[i] += GC[m]; }
        mm_ll<2>(qq, sUT, MLD, sBhT, MLD, mt, nt, fr, fq); mm_ll<2>(qq, sVt, MLD, sKhT, MLD, mt, nt, fr, fq);
        mm_ll<2>(rw, sArb, MLD, sWT, MLD, mt, nt, fr, fq);
        mm_ll<2>(yp, sArb, MLD, sUT, MLD, mt, nt, fr, fq); mm_ll<2>(yp, sArk, MLD, sVt, MLD, mt, nt, fr, fq);
        st_g(gPT, mt, nt, fr, fq, pt); st_g(gQ, mt, nt, fr, fq, qq); st_g(gRW, mt, nt, fr, fq, rw); st_g(gYP, mt, nt, fr, fq, yp); }
    BAR();
}
DI void rw_scan_chain(Frame& F, int chain) {
    const int mt = F.wave >> 1, nt0 = (F.wave & 1) * 2, fr = F.lane & 15, fq = F.lane >> 4;
    bf16* SB = (bf16*)(F.ws + WS_SB) + (size_t)chain * NCH * CHUNK_ELEMS;
    const bf16* gPT = chunk_PT(F) + (size_t)chain * NCH * CHUNK_ELEMS; const bf16* gQ = chunk_Q(F) + (size_t)chain * NCH * CHUNK_ELEMS;
    LAS bf16* S0 = slotp(F, 0); LAS bf16* S1 = slotp(F, 1);
    const f32x4 z = (f32x4){0.f, 0.f, 0.f, 0.f};
#pragma unroll
    for (int q = 0; q < 2; ++q) { st_n(S0, mt, nt0 + q, fr, fq, z); st_g(SB, mt, nt0 + q, fr, fq, z); }
    BAR();
    bf16x8 pb[2][2]; v2u qv[2];
#pragma unroll
    for (int q = 0; q < 2; ++q) { const int nt = nt0 + q;
#pragma unroll
        for (int s = 0; s < 2; ++s) pb[q][s] = *(const GAS bf16x8*)(gPT + (size_t)(nt * 16 + fr) * 64 + s * 32 + fq * 8);
        qv[q] = *(const GAS v2u*)(gQ + (mt * 16 + fr) * 64 + nt * 16 + 4 * fq); }
    for (int c = 0; c < NCH - 1; ++c) {
        const LAS bf16* cur = (c & 1) ? S1 : S0; LAS bf16* nxt = (c & 1) ? S0 : S1;
        bf16x8 pn[2][2]; v2u qn[2];
        const int cn = (c + 1 < NCH - 1) ? c + 1 : c;
#pragma unroll
        for (int q = 0; q < 2; ++q) { const int nt = nt0 + q;
#pragma unroll
            for (int s = 0; s < 2; ++s) pn[q][s] = *(const GAS bf16x8*)(gPT + (size_t)cn * CHUNK_ELEMS + (size_t)(nt * 16 + fr) * 64 + s * 32 + fq * 8);
            qn[q] = *(const GAS v2u*)(gQ + (size_t)cn * CHUNK_ELEMS + (mt * 16 + fr) * 64 + nt * 16 + 4 * fq); }
        bf16x8 a[2];
#pragma unroll
        for (int s = 0; s < 2; ++s) a[s] = *(const LAS bf16x8*)(cur + (mt * 16 + fr) * MLD + s * 32 + fq * 8);
#pragma unroll
        for (int q = 0; q < 2; ++q) { const int nt = nt0 + q; f32x4 acc = (f32x4){bflo(qv[q].x), bfhi(qv[q].x), bflo(qv[q].y), bfhi(qv[q].y)};
#pragma unroll
            for (int s = 0; s < 2; ++s) acc = MFMA16(pb[q][s], a[s], acc);
            st_n(nxt, mt, nt, fr, fq, acc); st_g(SB + (size_t)(c + 1) * CHUNK_ELEMS, mt, nt, fr, fq, acc); }
        BAR();
#pragma unroll
        for (int q = 0; q < 2; ++q) { qv[q] = qn[q];
#pragma unroll
            for (int s = 0; s < 2; ++s) pb[q][s] = pn[q][s]; }
    }
}
DI void rw_out_item(Frame& F, int b, int h, int c) {
    const bf16* proj = (const bf16*)(F.ws + WS_PROJ);
    const size_t ci = ((size_t)(b * NH + h) * NCH + c) * CHUNK_ELEMS;
    const int t = F.tid >> 3, cg = F.tid & 7;
    const int mt = F.wave >> 1, nt0 = (F.wave & 1) * 2, fr = F.lane & 15, fq = F.lane >> 4;
    LAS bf16* XG = slotp(F, 0); LAS float* Yf = (LAS float*)slotp(F, 3); LAS float* Gf = (LAS float*)slotp(F, 5);
    rw_gate_prep(F, proj, b, c, XG);
    const bf16* gRW = chunk_RW(F) + ci; const bf16* gYP = chunk_YP(F) + ci; const bf16* gS = (const bf16*)(F.ws + WS_SB) + ci;
#pragma unroll
    for (int q = 0; q < 2; ++q) { const int nt = nt0 + q; f32x4 y = ld_g(gYP, mt, nt, fr, fq);
        mm_gg<2>(y, gRW, 64, gS, 64, mt, nt, fr, fq);
        *(LAS f32x4*)(Yf + (mt * 16 + fr) * 64 + nt * 16 + 4 * fq) = y; }
    BAR();
    rw_gate_mm(F, h, XG, Gf);
    BAR();
    float y8[8], g8[8], v8[8]; lds_ld8f(Yf + t * 64 + cg * 8, y8); lds_ld8f(Gf + t * 64 + cg * 8, g8);
    const int tau = c * CH + t; const size_t row = (size_t)b * T + tau;
    load_shift8(proj, row, tau > 0, C_V + h * HD + cg * 8, F.shift_mu, v8);
    const float cb = ((const float*)(F.ws + WS_CB))[row * NH + h];
    rw_out_epi(F, b, h, c, y8, v8, cb, g8);
    BAR();
}


typedef short s16x4 __attribute__((ext_vector_type(4)));
DI bf16x8 fragN(const LAS bf16* Z, int row0, int k0, int fr, int fq) { return *(const LAS bf16x8*)(Z + (row0 + fr) * MLD + k0 + fq * 8); }
DI bf16x8 fragT(const LAS bf16* Z, int row0, int k0, int fr, int fq) {
    const LAS bf16* a = Z + (k0 + 8 * fq + (fr >> 2)) * MLD + row0 + 4 * (fr & 3);
    const s16x4 lo = __builtin_amdgcn_ds_read_tr16_b64_v4i16((LAS s16x4*)a);
    const s16x4 hi = __builtin_amdgcn_ds_read_tr16_b64_v4i16((LAS s16x4*)(a + 4 * MLD));
    return __builtin_shufflevector(lo, hi, 0, 1, 2, 3, 4, 5, 6, 7);
}
template <bool TA, bool TB> DI void mm2(f32x4& acc, const LAS bf16* ZA, const LAS bf16* ZB, int mt, int nt, int fr, int fq) {
#pragma unroll
    for (int s = 0; s < 2; ++s) { const bf16x8 a = TA ? fragT(ZA, mt * 16, s * 32, fr, fq) : fragN(ZA, mt * 16, s * 32, fr, fq); const bf16x8 b = TB ? fragT(ZB, nt * 16, s * 32, fr, fq) : fragN(ZB, nt * 16, s * 32, fr, fq);
        acc = MFMA16(b, a, acc); }
}
DI float fexp(float x) { return __expf(x); }
DI float frcp(float x) { return __builtin_amdgcn_rcpf(x); }
DI float fsigmoid(float x) { return frcp(1.0f + __expf(-x)); }
DI float ftanh(float x) { return 1.0f - 2.0f * frcp(1.0f + __expf(2.0f * x)); }
constexpr int PAR_OFF = LDSCTL_OFF + 1024;
struct RawRKV { v4u rc, rp, kc, kp, vc, vp; };
struct LoraB { bf16x8 w[2][2], a[2][2]; };
DI void rkv_issue(const bf16* proj, int b, int h, int c, int t, int cg, RawRKV& R) {
    const int tau = c * CH + t; const size_t row = (size_t)b * T + tau, prow = row - (tau > 0 ? 1 : 0); const int col = h * HD + cg * 8;
    R.rc = *(const GAS v4u*)(proj + row * PROJ_LD + C_R + col); R.rp = *(const GAS v4u*)(proj + prow * PROJ_LD + C_R + col);
    R.kc = *(const GAS v4u*)(proj + row * PROJ_LD + C_K + col); R.kp = *(const GAS v4u*)(proj + prow * PROJ_LD + C_K + col);
    R.vc = *(const GAS v4u*)(proj + row * PROJ_LD + C_V + col); R.vp = *(const GAS v4u*)(proj + prow * PROJ_LD + C_V + col);
}
DI void lora_issue(Frame& F, int h, int nt0, int fr, int fq, LoraB& L) {
    const bf16* WL = (const bf16*)(F.ws + WS_WL) + (size_t)h * HD * RANK_W; const bf16* AL = (const bf16*)(F.ws + WS_AL) + (size_t)h * HD * RANK_A;
#pragma unroll
    for (int q = 0; q < 2; ++q)
#pragma unroll
        for (int s = 0; s < 2; ++s) { L.w[q][s] = *(const GAS bf16x8*)(WL + (size_t)((nt0 + q) * 16 + fr) * RANK_W + s * 32 + fq * 8); L.a[q][s] = *(const GAS bf16x8*)(AL + (size_t)((nt0 + q) * 16 + fr) * RANK_A + s * 32 + fq * 8); }
}
DI void shift8(const v4u c, const v4u p, bool hp, const LAS float* mu, float (&o)[8]) {
    float cu[8], pr[8], m[8]; unpack8(c, cu); unpack8(p, pr); lds_ld8f(mu, m);
#pragma unroll
    for (int j = 0; j < 8; ++j) { const float pv = hp ? pr[j] : 0.f; o[j] = cu[j] + m[j] * (pv - cu[j]); }
}
DI void rw_chunk_wg(Frame& F, int b, int c) {
    const bf16* proj = (const bf16*)(F.ws + WS_PROJ);
    const int t = F.tid >> 3, cg = F.tid & 7;
    const int mt = F.wave >> 1, nt0 = (F.wave & 1) * 2, fr = F.lane & 15, fq = F.lane >> 4;
    const bool hp = (c * CH + t) > 0;
    LAS bf16* XW = slotp(F, 0); LAS bf16* XA = slotp(F, 1);
    LAS bf16* sAt = slotp(F, 2); LAS bf16* sRt = slotp(F, 3); LAS bf16* sBt = slotp(F, 4); LAS bf16* sKt = slotp(F, 5); LAS bf16* sBh = slotp(F, 6); LAS bf16* sKh = slotp(F, 7); LAS bf16* sV = slotp(F, 8);
    LAS float* LW = (LAS float*)slotp(F, 9); LAS float* IC = LW + 4096; LAS float* SEG = (LAS float*)slotp(F, 15);
    LAS bf16* sN = slotp(F, 9); LAS bf16* sAak = slotp(F, 10); LAS bf16* sArb = slotp(F, 11); LAS bf16* sArk = slotp(F, 12); LAS bf16* sTa = slotp(F, 13); LAS bf16* sTb = slotp(F, 14);
    LAS bf16* sNpb = slotp(F, 4); LAS bf16* sM1 = slotp(F, 5); LAS bf16* sW = slotp(F, 9); LAS bf16* sU = slotp(F, 10);
    LAS float* GC = (LAS float*)(F.lds + LDSCTL_OFF + 512);
    LAS float* PAR = (LAS float*)(F.lds + PAR_OFF);
    PAR[F.tid] = F.k_k[F.tid]; PAR[512 + F.tid] = F.k_a[F.tid]; PAR[1024 + F.tid] = F.r_k[F.tid];
    PAR[1536 + F.tid] = F.shift_mu[F.tid]; PAR[2048 + F.tid] = F.shift_mu[512 + F.tid]; PAR[2560 + F.tid] = F.shift_mu[1024 + F.tid];
    {   float xw[8], xa[8]; const size_t row = (size_t)b * T + c * CH + t;
        load_shift8(proj, row, hp, C_XW + cg * 8, F.shift_mu, xw); load_shift8(proj, row, hp, C_XA + cg * 8, F.shift_mu, xa);
#pragma unroll
        for (int j = 0; j < 8; ++j) xw[j] = ftanh(xw[j]);
        *(LAS v4u*)(XW + t * MLD + cg * 8) = pack8(xw); *(LAS v4u*)(XA + t * MLD + cg * 8) = pack8(xa); }
    RawRKV cur; rkv_issue(proj, b, 0, c, t, cg, cur);
    LoraB lb; lora_issue(F, 0, nt0, fr, fq, lb);
    BAR();
#pragma unroll 1
    for (int h = 0; h < NH; ++h) {
        const size_t ci = ((size_t)(b * NH + h) * NCH + c) * CHUNK_ELEMS;
#pragma unroll
        for (int q = 0; q < 2; ++q) { const int nt = nt0 + q, n0 = nt * 16 + 4 * fq; f32x4 aw = (f32x4){0.f, 0.f, 0.f, 0.f}, aa = aw;
#pragma unroll
            for (int s = 0; s < 2; ++s) { const bf16x8 xw = fragN(XW, mt * 16, s * 32, fr, fq), xa = fragN(XA, mt * 16, s * 32, fr, fq); aw = MFMA16(lb.w[q][s], xw, aw); aa = MFMA16(lb.a[q][s], xa, aa); }
            const f32x4 w0v = *(const GAS f32x4*)(F.w0 + h * HD + n0), a0v = *(const GAS f32x4*)(F.a0 + h * HD + n0);
            f32x4 lw, ic;
#pragma unroll
            for (int i = 0; i < 4; ++i) { const float xs = -(aw[i] + w0v[i]); const float sp = fmaxf(xs, 0.f) + __logf(1.0f + fexp(-fabsf(xs))); lw[i] = -fexp(-sp - 0.5f); ic[i] = fsigmoid(aa[i] + a0v[i]); }
            *(LAS f32x4*)(LW + (mt * 16 + fr) * 64 + n0) = lw; *(LAS f32x4*)(IC + (mt * 16 + fr) * 64 + n0) = ic; }
        const int hn = (h + 1 < NH) ? h + 1 : h;
        BAR();
        {
            const int seg = F.wave, kc = F.lane; float pfx[8]; float run = 0.f;
#pragma unroll
            for (int j = 0; j < 8; ++j) { run += LW[(seg * 8 + j) * 64 + kc]; pfx[j] = run; }
            SEG[seg * 64 + kc] = run;
            BAR();
            float off = 0.f;
#pragma unroll
            for (int s = 0; s < 8; ++s) { const float sv = SEG[s * 64 + kc]; off += (s < seg) ? sv : 0.f; }
#pragma unroll
            for (int j = 0; j < 8; ++j) LW[(seg * 8 + j) * 64 + kc] = pfx[j] + off;
            BAR();
        }
        {
            float r8[8], k8[8], v8[8];
            shift8(cur.rc, cur.rp, hp, PAR + 1536 + h * HD + cg * 8, r8); shift8(cur.kc, cur.kp, hp, PAR + 2048 + h * HD + cg * 8, k8); shift8(cur.vc, cur.vp, hp, PAR + 2560 + h * HD + cg * 8, v8);
            float Lt[8], Lm[8], LC[8], ic[8];
            lds_ld8f(LW + t * 64 + cg * 8, Lt); lds_ld8f(LW + 63 * 64 + cg * 8, LC); lds_ld8f(IC + t * 64 + cg * 8, ic);
            lds_ld8f(LW + (t > 0 ? t - 1 : 0) * 64 + cg * 8, Lm);
            if (t == 0) {
#pragma unroll
                for (int j = 0; j < 8; ++j) Lm[j] = 0.f; }
            float kkw[8], kaw[8], rkw[8]; lds_ld8f(PAR + h * HD + cg * 8, kkw); lds_ld8f(PAR + 512 + h * HD + cg * 8, kaw); lds_ld8f(PAR + 1024 + h * HD + cg * 8, rkw);
            float kk[8], ss = 0.f;
#pragma unroll
            for (int j = 0; j < 8; ++j) { kk[j] = k8[j] * kkw[j]; ss += kk[j] * kk[j]; }
            const float inv = rsqrtf(fmaxf(red8(ss), 1e-24f));
            float at[8], rt[8], bt[8], kt[8], bh[8], khh[8], cbp = 0.f;
#pragma unroll
            for (int j = 0; j < 8; ++j) { const float kn = kk[j] * inv; const float kh = k8[j] * (1.0f + (ic[j] - 1.0f) * kaw[j]); const float bb = kn * ic[j];
                const float em = fexp(Lm[j]), et = fexp(Lt[j]), en = fexp(-Lt[j]), ec = fexp(LC[j] - Lt[j]);
                at[j] = -kn * em; rt[j] = r8[j] * et; bt[j] = bb * en; kt[j] = kh * en; bh[j] = bb * ec; khh[j] = kh * ec; cbp += r8[j] * kh * rkw[j]; }
            const float cb = red8(cbp);
            if (cg == 0) ((float*)(F.ws + WS_CB))[((size_t)b * T + c * CH + t) * NH + h] = cb;
            if (t == 63) {
#pragma unroll
                for (int j = 0; j < 8; ++j) GC[cg * 8 + j] = fexp(LC[j]); }
            *(LAS v4u*)(sAt + t * MLD + cg * 8) = pack8(at); *(LAS v4u*)(sRt + t * MLD + cg * 8) = pack8(rt); *(LAS v4u*)(sBt + t * MLD + cg * 8) = pack8(bt); *(LAS v4u*)(sKt + t * MLD + cg * 8) = pack8(kt);
            *(LAS v4u*)(sBh + t * MLD + cg * 8) = pack8(bh); *(LAS v4u*)(sKh + t * MLD + cg * 8) = pack8(khh); *(LAS v4u*)(sV + t * MLD + cg * 8) = pack8(v8);
        }
        rkv_issue(proj, b, hn, c, t, cg, cur);
        BAR();
#pragma unroll
        for (int q = 0; q < 2; ++q) { const int nt = nt0 + q; const f32x4 z = (f32x4){0.f, 0.f, 0.f, 0.f};
            f32x4 ab = z, ak = z, rb = z, rk = z;
            if (nt <= mt) { mm2<false, false>(ab, sAt, sBt, mt, nt, fr, fq); mm2<false, false>(ak, sAt, sKt, mt, nt, fr, fq); mm2<false, false>(rb, sRt, sBt, mt, nt, fr, fq); mm2<false, false>(rk, sRt, sKt, mt, nt, fr, fq); }
            const int m = mt * 16 + fr; f32x4 t0;
#pragma unroll
            for (int i = 0; i < 4; ++i) { const int n = nt * 16 + 4 * fq + i; if (!(n < m)) { ab[i] = 0.f; ak[i] = 0.f; } if (!(n <= m)) { rb[i] = 0.f; rk[i] = 0.f; } t0[i] = ab[i] + ((n == m) ? 1.0f : 0.f); }
            st_n(sN, mt, nt, fr, fq, ab); st_n(sTa, mt, nt, fr, fq, t0); st_n(sAak, mt, nt, fr, fq, ak); st_n(sArb, mt, nt, fr, fq, rb); st_n(sArk, mt, nt, fr, fq, rk); }
        BAR();
#pragma unroll
        for (int q = 0; q < 2; ++q) { const int nt = nt0 + q; f32x4 n2 = (f32x4){0.f, 0.f, 0.f, 0.f}, m1 = n2;
            mm2<false, true>(n2, sN, sN, mt, nt, fr, fq); mm2<false, true>(m1, sAak, sV, mt, nt, fr, fq);
            st_n(sNpb, mt, nt, fr, fq, n2); st_n(sM1, mt, nt, fr, fq, m1); }
        BAR();
#pragma unroll 1
        for (int it = 1; it <= 5 + MK_XIT; ++it) {
            const bool odd = it & 1;
            const LAS bf16* cT = odd ? sTa : sTb; const LAS bf16* cNp = odd ? sNpb : sN; LAS bf16* dT = odd ? sTb : sTa; LAS bf16* dNp = odd ? sN : sNpb;
#pragma unroll
            for (int q = 0; q < 2; ++q) { const int nt = nt0 + q; f32x4 tn = ld_tile(cT, mt, nt, fr, fq);
                mm2<false, true>(tn, cT, cNp, mt, nt, fr, fq); st_n(dT, mt, nt, fr, fq, tn);
                if (it < 5 + MK_XIT) { f32x4 n2 = (f32x4){0.f, 0.f, 0.f, 0.f}; mm2<false, true>(n2, cNp, cNp, mt, nt, fr, fq); st_n(dNp, mt, nt, fr, fq, n2); } }
            BAR();
        }
        lora_issue(F, hn, nt0, fr, fq, lb);
#pragma unroll
        for (int q = 0; q < 2; ++q) { const int nt = nt0 + q; f32x4 w = (f32x4){0.f, 0.f, 0.f, 0.f}, u = w;
            mm2<false, true>(w, sTb, sAt, mt, nt, fr, fq); mm2<false, true>(u, sTb, sM1, mt, nt, fr, fq);
            st_n(sW, mt, nt, fr, fq, w); st_n(sU, mt, nt, fr, fq, u); }
        BAR();
        bf16* gPT = chunk_PT(F) + ci; bf16* gQ = chunk_Q(F) + ci; bf16* gRW = chunk_RW(F) + ci; bf16* gYP = chunk_YP(F) + ci;
#pragma unroll 1
        for (int xr = 0; xr < 1 + MK_XM5; ++xr)
#pragma unroll
        for (int q = 0; q < 2; ++q) { const int nt = nt0 + q; const f32x4 z = (f32x4){0.f, 0.f, 0.f, 0.f};
            f32x4 pt = z, qq = z, rw = ld_tile(sRt, mt, nt, fr, fq), yp = z;
            mm2<true, true>(pt, sBh, sW, mt, nt, fr, fq);
            const int m = mt * 16 + fr;
#pragma unroll
            for (int i = 0; i < 4; ++i) { const int n = nt * 16 + 4 * fq + i; if (n == m) pt[i] += GC[m]; }
            mm2<true, true>(qq, sU, sBh, mt, nt, fr, fq); mm2<true, true>(qq, sV, sKh, mt, nt, fr, fq);
            mm2<false, true>(rw, sArb, sW, mt, nt, fr, fq);
            mm2<false, true>(yp, sArb, sU, mt, nt, fr, fq); mm2<false, true>(yp, sArk, sV, mt, nt, fr, fq);
            st_g(gPT, mt, nt, fr, fq, pt); st_g(gQ, mt, nt, fr, fq, qq); st_g(gRW, mt, nt, fr, fq, rw); st_g(gYP, mt, nt, fr, fq, yp); }
        BAR();
    }
}

DI bf16x8 q32N(const LAS bf16* Z, int row0, int s, int lane) { return *(const LAS bf16x8*)(Z + (row0 + (lane & 31)) * MLD + s * 16 + (lane >> 5) * 8); }
DI bf16x8 q32T(const LAS bf16* Z, int row0, int s, int lane) {
    const int i = lane & 15, g = lane >> 4;
    const LAS bf16* a = Z + (s * 16 + (g >> 1) * 8 + (i >> 2)) * MLD + row0 + (g & 1) * 16 + 4 * (i & 3);
    const s16x4 lo = __builtin_amdgcn_ds_read_tr16_b64_v4i16((LAS s16x4*)a);
    const s16x4 hi = __builtin_amdgcn_ds_read_tr16_b64_v4i16((LAS s16x4*)(a + 4 * MLD));
    return __builtin_shufflevector(lo, hi, 0, 1, 2, 3, 4, 5, 6, 7);
}
template <bool TA, bool TB> DI void mm32(f32x16& acc, const LAS bf16* ZA, const LAS bf16* ZB, int m0, int n0, int lane) {
#pragma unroll
    for (int s = 0; s < 4; ++s) { const bf16x8 a = TA ? q32T(ZA, m0, s, lane) : q32N(ZA, m0, s, lane); const bf16x8 b = TB ? q32T(ZB, n0, s, lane) : q32N(ZB, n0, s, lane);
        acc = MFMA32(b, a, acc); }
}
DI void st32(LAS bf16* Dst, int m0, int n0, int lane, const f32x16& v) {
    LAS bf16* p = Dst + (m0 + (lane & 31)) * MLD + n0 + 4 * (lane >> 5);
#pragma unroll
    for (int g = 0; g < 4; ++g) { v2u w; w.x = pk2(v[4 * g], v[4 * g + 1]); w.y = pk2(v[4 * g + 2], v[4 * g + 3]); *(LAS v2u*)(p + 8 * g) = w; }
}
DI void ld32(const LAS bf16* Src, int m0, int n0, int lane, f32x16& v) {
    const LAS bf16* p = Src + (m0 + (lane & 31)) * MLD + n0 + 4 * (lane >> 5);
#pragma unroll
    for (int g = 0; g < 4; ++g) { const v2u w = *(const LAS v2u*)(p + 8 * g); v[4 * g] = bflo(w.x); v[4 * g + 1] = bfhi(w.x); v[4 * g + 2] = bflo(w.y); v[4 * g + 3] = bfhi(w.y); }
}
DI void stg32(bf16* Dst, int m0, int n0, int lane, const f32x16& v) {
    bf16* p = Dst + (m0 + (lane & 31)) * 64 + n0 + 4 * (lane >> 5);
#pragma unroll
    for (int g = 0; g < 4; ++g) { v2u w; w.x = pk2(v[4 * g], v[4 * g + 1]); w.y = pk2(v[4 * g + 2], v[4 * g + 3]); *(GAS v2u*)(p + 8 * g) = w; }
}
DI f32x16 zero16() { f32x16 z;
#pragma unroll
    for (int e = 0; e < 16; ++e) z[e] = 0.f;
    return z; }
struct LoraB3 { bf16x8 f[4]; };
DI void lora_issue3(Frame& F, int h, int sel, int n0, int lane, LoraB3& L) {
    const bf16* Wm = (const bf16*)(F.ws + (sel ? WS_AL : WS_WL)) + (size_t)h * HD * 64;
#pragma unroll
    for (int s = 0; s < 4; ++s) L.f[s] = *(const GAS bf16x8*)(Wm + (size_t)(n0 + (lane & 31)) * 64 + s * 16 + (lane >> 5) * 8);
}
DI int frag_off(int ri, int n0, int g, int lh) { return ((ri >> 4) * 2 + (n0 >> 5)) * 512 + (2 * (g & 1) + lh) * 128 + (ri & 15) * 8 + 4 * (g >> 1); }
DI void stg32f(bf16* Dst, int m0, int n0, int lane, const f32x16& v) {
#pragma unroll
    for (int g = 0; g < 4; ++g) { v2u w; w.x = pk2(v[4 * g], v[4 * g + 1]); w.y = pk2(v[4 * g + 2], v[4 * g + 3]); *(GAS v2u*)(Dst + frag_off(m0 + (lane & 31), n0, g, lane >> 5)) = w; }
}

DI void rw_chunk_wg3(Frame& F, int b, int c) {
    const bf16* proj = (const bf16*)(F.ws + WS_PROJ);
    const int t = F.tid >> 3, cg = F.tid & 7, lane = F.lane;
    const int sel = F.wave >> 2, qd = F.wave & 3, m0 = (qd >> 1) * 32, n0 = (qd & 1) * 32, lr = lane & 31, lh = lane >> 5;
    const bool hp = (c * CH + t) > 0;
    LAS bf16* XW = slotp(F, 0); LAS bf16* XA = slotp(F, 1);
    LAS bf16* sAt = slotp(F, 2); LAS bf16* sRt = slotp(F, 3); LAS bf16* sBt = slotp(F, 4); LAS bf16* sKt = slotp(F, 5); LAS bf16* sV = slotp(F, 6); LAS bf16* sNpb = slotp(F, 7); LAS bf16* sM1 = slotp(F, 8);
    LAS float* LW = (LAS float*)slotp(F, 9); LAS float* IC = LW + 4096; LAS float* SEG = (LAS float*)slotp(F, 15);
    LAS bf16* sN = slotp(F, 9); LAS bf16* sAak = slotp(F, 10); LAS bf16* sArb = slotp(F, 11); LAS bf16* sArk = slotp(F, 12); LAS bf16* sTa = slotp(F, 13); LAS bf16* sTb = slotp(F, 14);
    LAS bf16* sW = slotp(F, 9); LAS bf16* sU = slotp(F, 10);
    LAS float* GC = (LAS float*)(F.lds + LDSCTL_OFF + 512);
    LAS float* PAR = (LAS float*)(F.lds + PAR_OFF);
    LAS float* PW0 = SEG + 1024; LAS float* PA0 = SEG + 1536;
    RawRKV cur; rkv_issue(proj, b, 0, c, t, cg, cur);
    LoraB3 lb; lora_issue3(F, 0, sel, n0, lane, lb);
    {   const float p0 = F.k_k[F.tid], p1 = F.k_a[F.tid], p2 = F.r_k[F.tid], p3 = F.shift_mu[F.tid], p4 = F.shift_mu[512 + F.tid], p5 = F.shift_mu[1024 + F.tid], p6 = F.w0[F.tid], p7 = F.a0[F.tid];
        float xw[8], xa[8]; const size_t row = (size_t)b * T + c * CH + t;
        load_shift8(proj, row, hp, C_XW + cg * 8, F.shift_mu, xw); load_shift8(proj, row, hp, C_XA + cg * 8, F.shift_mu, xa);
        PAR[F.tid] = p0; PAR[512 + F.tid] = p1; PAR[1024 + F.tid] = p2; PAR[1536 + F.tid] = p3; PAR[2048 + F.tid] = p4; PAR[2560 + F.tid] = p5; PW0[F.tid] = p6; PA0[F.tid] = p7;
#pragma unroll
        for (int j = 0; j < 8; ++j) xw[j] = ftanh(xw[j]);
        *(LAS v4u*)(XW + t * MLD + cg * 8) = pack8(xw); *(LAS v4u*)(XA + t * MLD + cg * 8) = pack8(xa); }
    BAR();
#pragma unroll 1
    for (int h = 0; h < NH; ++h) {
        const size_t ci = ((size_t)(b * NH + h) * NCH + c) * CHUNK_ELEMS;
        const int hn = (h + 1 < NH) ? h + 1 : h;
        {
            f32x16 z = zero16();
            const LAS bf16* X = sel ? XA : XW;
#pragma unroll
            for (int s = 0; s < 4; ++s) z = MFMA32(lb.f[s], q32N(X, m0, s, lane), z);
            const LAS float* bias = (sel ? PA0 : PW0) + h * HD + n0 + 4 * lh; LAS float* dst = (sel ? IC : LW) + (m0 + lr) * 64 + n0 + 4 * lh;
            if (sel) {
#pragma unroll
                for (int g = 0; g < 4; ++g) { const f32x4 bv = *(const LAS f32x4*)(bias + 8 * g); f32x4 o;
#pragma unroll
                    for (int e = 0; e < 4; ++e) o[e] = fsigmoid(z[4 * g + e] + bv[e]);
                    *(LAS f32x4*)(dst + 8 * g) = o; }
            } else {
#pragma unroll
                for (int g = 0; g < 4; ++g) { const f32x4 bv = *(const LAS f32x4*)(bias + 8 * g); f32x4 o;
#pragma unroll
                    for (int e = 0; e < 4; ++e) { const float xs = -(z[4 * g + e] + bv[e]); const float sp = fmaxf(xs, 0.f) + __logf(1.0f + fexp(-fabsf(xs))); o[e] = -fexp(-sp - 0.5f); }
                    *(LAS f32x4*)(dst + 8 * g) = o; }
            }
        }
        BAR();
        {
            const int seg = F.wave, kc = F.lane; float pfx[8]; float run = 0.f;
#pragma unroll
            for (int j = 0; j < 8; ++j) { run += LW[(seg * 8 + j) * 64 + kc]; pfx[j] = run; }
            SEG[seg * 64 + kc] = run;
            BAR();
            float off = 0.f;
#pragma unroll
            for (int s = 0; s < 8; ++s) { const float sv = SEG[s * 64 + kc]; off += (s < seg) ? sv : 0.f; }
#pragma unroll
            for (int j = 0; j < 8; ++j) LW[(seg * 8 + j) * 64 + kc] = pfx[j] + off;
            BAR();
        }
        {
            float r8[8], k8[8], v8[8];
            shift8(cur.rc, cur.rp, hp, PAR + 1536 + h * HD + cg * 8, r8); shift8(cur.kc, cur.kp, hp, PAR + 2048 + h * HD + cg * 8, k8); shift8(cur.vc, cur.vp, hp, PAR + 2560 + h * HD + cg * 8, v8);
            float Lt[8], Lm[8], ic[8];
            lds_ld8f(LW + t * 64 + cg * 8, Lt); lds_ld8f(IC + t * 64 + cg * 8, ic);
            lds_ld8f(LW + (t > 0 ? t - 1 : 0) * 64 + cg * 8, Lm);
            if (t == 0) {
#pragma unroll
                for (int j = 0; j < 8; ++j) Lm[j] = 0.f; }
            float kkw[8], kaw[8], rkw[8]; lds_ld8f(PAR + h * HD + cg * 8, kkw); lds_ld8f(PAR + 512 + h * HD + cg * 8, kaw); lds_ld8f(PAR + 1024 + h * HD + cg * 8, rkw);
            float kk[8], ss = 0.f;
#pragma unroll
            for (int j = 0; j < 8; ++j) { kk[j] = k8[j] * kkw[j]; ss += kk[j] * kk[j]; }
            const float inv = rsqrtf(fmaxf(red8(ss), 1e-24f));
            float at[8], rt[8], bt[8], kt[8], cbp = 0.f;
#pragma unroll
            for (int j = 0; j < 8; ++j) { const float kn = kk[j] * inv; const float kh = k8[j] * (1.0f + (ic[j] - 1.0f) * kaw[j]); const float bb = kn * ic[j];
                const float em = fexp(Lm[j]), et = fexp(Lt[j]), en = fexp(-Lt[j]);
                at[j] = -kn * em; rt[j] = r8[j] * et; bt[j] = bb * en; kt[j] = kh * en; cbp += r8[j] * kh * rkw[j]; }
            const float cb = red8(cbp);
            if (cg == 0) ((float*)(F.ws + WS_CB))[((size_t)b * T + c * CH + t) * NH + h] = cb;
            if (t == 63) {
#pragma unroll
                for (int j = 0; j < 8; ++j) GC[cg * 8 + j] = fexp(Lt[j]); }
            *(LAS v4u*)(sAt + t * MLD + cg * 8) = pack8(at); *(LAS v4u*)(sRt + t * MLD + cg * 8) = pack8(rt); *(LAS v4u*)(sBt + t * MLD + cg * 8) = pack8(bt); *(LAS v4u*)(sKt + t * MLD + cg * 8) = pack8(kt);
            *(LAS v4u*)(sV + t * MLD + cg * 8) = pack8(v8);
        }
        rkv_issue(proj, b, hn, c, t, cg, cur);
        BAR();
        {
            const LAS bf16* ZA = (qd & 2) ? sRt : sAt; const LAS bf16* ZB = (qd & 1) ? sKt : sBt; LAS bf16* dst = (qd == 0) ? sN : (qd == 1) ? sAak : (qd == 2) ? sArb : sArk; const bool incl = (qd & 2) != 0;
            if (sel == 0) { f32x16 a = zero16(); mm32<false, false>(a, ZA, ZB, 32, 0, lane); st32(dst, 32, 0, lane, a); if (qd == 0) st32(sTa, 32, 0, lane, a); }
            else { const f32x16 z = zero16(); st32(dst, 0, 32, lane, z); if (qd == 0) st32(sTa, 0, 32, lane, z); }
            const int d0 = sel ? 32 : 0; f32x16 a = zero16(); mm32<false, false>(a, ZA, ZB, d0, d0, lane);
            f32x16 t0;
#pragma unroll
            for (int e = 0; e < 16; ++e) { const int n = 8 * (e >> 2) + 4 * lh + (e & 3); const bool keep = incl ? (n <= lr) : (n < lr); a[e] = keep ? a[e] : 0.f; t0[e] = a[e] + ((n == lr) ? 1.0f : 0.f); }
            st32(dst, d0, d0, lane, a); if (qd == 0) st32(sTa, d0, d0, lane, t0);
        }
        BAR();
        {
            f32x16 a = zero16();
            if (sel == 0) { mm32<false, true>(a, sN, sN, m0, n0, lane); st32(sNpb, m0, n0, lane, a); }
            else { mm32<false, true>(a, sAak, sV, m0, n0, lane); st32(sM1, m0, n0, lane, a); }
        }
        BAR();
#pragma unroll 1
        for (int it = 1; it <= 5 + MK_XIT; ++it) {
            const bool odd = it & 1;
            const LAS bf16* cT = odd ? sTa : sTb; const LAS bf16* cNp = odd ? sNpb : sN; LAS bf16* dT = odd ? sTb : sTa; LAS bf16* dNp = odd ? sN : sNpb;
            if (sel == 0) { f32x16 a; ld32(cT, m0, n0, lane, a); mm32<false, true>(a, cT, cNp, m0, n0, lane); st32(dT, m0, n0, lane, a); }
            else if (it < 5 + MK_XIT) { f32x16 a = zero16(); mm32<false, true>(a, cNp, cNp, m0, n0, lane); st32(dNp, m0, n0, lane, a); }
            BAR();
        }
        lora_issue3(F, hn, sel, n0, lane, lb);
        {
            f32x16 a = zero16();
            if (sel == 0) { mm32<false, true>(a, sTb, sAt, m0, n0, lane); st32(sW, m0, n0, lane, a); }
            else { mm32<false, true>(a, sTb, sM1, m0, n0, lane); st32(sU, m0, n0, lane, a); }
        }
        BAR();
        {
            bf16* gPT = chunk_PT(F) + ci; bf16* gQ = chunk_Q(F) + ci; bf16* gRW = chunk_RW(F) + ci; bf16* gYP = chunk_YP(F) + ci;
#pragma unroll 1
            for (int xr = 0; xr < 1 + MK_XM5; ++xr) {
            if (sel == 0) {
                f32x16 pt = zero16(); mm32<true, true>(pt, sBt, sW, m0, n0, lane);
                const float gm = GC[m0 + lr];
#pragma unroll
                for (int e = 0; e < 16; ++e) { const int n = n0 + 8 * (e >> 2) + 4 * lh + (e & 3); pt[e] = gm * (pt[e] + ((n == m0 + lr) ? 1.0f : 0.f)); }
                stg32f(gPT, m0, n0, lane, pt);
                f32x16 qq = zero16(); mm32<true, true>(qq, sU, sBt, m0, n0, lane); mm32<true, true>(qq, sV, sKt, m0, n0, lane);
#pragma unroll
                for (int g = 0; g < 4; ++g) { const f32x4 gc = *(const LAS f32x4*)(GC + n0 + 8 * g + 4 * lh);
#pragma unroll
                    for (int e = 0; e < 4; ++e) qq[4 * g + e] *= gc[e]; }
                stg32f(gQ, m0, n0, lane, qq);
            } else {
                f32x16 rw; ld32(sRt, m0, n0, lane, rw); mm32<false, true>(rw, sArb, sW, m0, n0, lane); stg32(gRW, m0, n0, lane, rw);
                f32x16 yp = zero16(); mm32<false, true>(yp, sArb, sU, m0, n0, lane); mm32<false, true>(yp, sArk, sV, m0, n0, lane); stg32(gYP, m0, n0, lane, yp);
            } }
        }
        BAR();
    }
}

constexpr int SC_D = 5, SC_SLOT = 10240;
DI void sc_issue(const bf16* gPT, const bf16* gQ, LAS unsigned char* ring, int c, int lane) {
    LAS unsigned char* dst = ring + (c % SC_D) * SC_SLOT;
#pragma unroll
    for (int blk = 0; blk < 8; ++blk) __builtin_amdgcn_global_load_lds((const unsigned*)(gPT + (size_t)c * CHUNK_ELEMS + blk * 512 + lane * 8), (LAS unsigned*)(dst + blk * 1024), 16, 0, 0);
#pragma unroll
    for (int blk = 0; blk < 2; ++blk) __builtin_amdgcn_global_load_lds((const unsigned*)(gQ + (size_t)c * CHUNK_ELEMS + blk * 512 + lane * 8), (LAS unsigned*)(dst + 8192 + blk * 1024), 16, 0, 0);
}
DI void rw_scan_task(Frame& F, int task) {
    const int chain = task >> 2, sl = task & 3, lane = F.lane, fr = lane & 15, fq = lane >> 4;
    const bf16* gPT = chunk_PT(F) + (size_t)chain * NCH * CHUNK_ELEMS;
    const bf16* gQ = chunk_Q(F) + (size_t)chain * NCH * CHUNK_ELEMS + sl * 1024;
    bf16* SB = (bf16*)(F.ws + WS_SB) + (size_t)chain * NCH * CHUNK_ELEMS + (size_t)(16 * sl + fr) * 64 + 4 * fq;
    LAS unsigned char* ring = F.lds;
    f32x4 acc[4];
#pragma unroll
    for (int nt = 0; nt < 4; ++nt) { acc[nt] = (f32x4){0.f, 0.f, 0.f, 0.f}; *(GAS v2u*)(SB + 16 * nt) = (v2u){0u, 0u}; }
#pragma unroll
    for (int c = 0; c < SC_D - 1; ++c) sc_issue(gPT, gQ, ring, c, lane);
#pragma unroll 1
    for (int c = 0; c < NCH - 1; ++c) {
        if (c + SC_D - 1 < NCH - 1) { sc_issue(gPT, gQ, ring, c + SC_D - 1, lane); asm volatile("s_waitcnt vmcnt(40)" ::: "memory"); }
        else asm volatile("s_waitcnt vmcnt(0)" ::: "memory");
        const LAS unsigned char* src = ring + (c % SC_D) * SC_SLOT + lane * 16;
        bf16x8 bq[4][2]; v4u qv[2];
#pragma unroll
        for (int nt = 0; nt < 4; ++nt)
#pragma unroll
            for (int ks = 0; ks < 2; ++ks) bq[nt][ks] = *(const LAS bf16x8*)(src + (nt * 2 + ks) * 1024);
#pragma unroll
        for (int blk = 0; blk < 2; ++blk) qv[blk] = *(const LAS v4u*)(src + 8192 + blk * 1024);
        bf16x8 a[2];
#pragma unroll
        for (int ks = 0; ks < 2; ++ks) { v4u w; w.x = pk2(acc[2 * ks][0], acc[2 * ks][1]); w.y = pk2(acc[2 * ks][2], acc[2 * ks][3]); w.z = pk2(acc[2 * ks + 1][0], acc[2 * ks + 1][1]); w.w = pk2(acc[2 * ks + 1][2], acc[2 * ks + 1][3]); a[ks] = __builtin_bit_cast(bf16x8, w); }
#pragma unroll
        for (int nt = 0; nt < 4; ++nt) { const unsigned q0 = (nt & 1) ? qv[nt >> 1].z : qv[nt >> 1].x, q1 = (nt & 1) ? qv[nt >> 1].w : qv[nt >> 1].y;
            f32x4 n = (f32x4){bflo(q0), bfhi(q0), bflo(q1), bfhi(q1)};
#pragma unroll
            for (int ks = 0; ks < 2; ++ks) n = MFMA16(bq[nt][ks], a[ks], n);
            acc[nt] = n; }
        asm volatile("s_waitcnt lgkmcnt(0)" ::: "memory");
#pragma unroll
        for (int nt = 0; nt < 4; ++nt) { v2u w; w.x = pk2(acc[nt][0], acc[nt][1]); w.y = pk2(acc[nt][2], acc[nt][3]); *(GAS v2u*)(SB + (size_t)(c + 1) * CHUNK_ELEMS + 16 * nt) = w; }
    }
    asm volatile("s_waitcnt vmcnt(0)" ::: "memory");
}

DI void rw_out_chunk(Frame& F, int b, int c) {
    const bf16* proj = (const bf16*)(F.ws + WS_PROJ);
    LAS bf16* XG = slotp(F, 0);
    rw_gate_prep(F, proj, b, c, XG);
    const int h = F.wave, r = F.lane & 31, hh = F.lane >> 5;
    const size_t ci = ((size_t)(b * NH + h) * NCH + c) * CHUNK_ELEMS;
    const bf16* gRW = chunk_RW(F) + ci; const bf16* gYP = chunk_YP(F) + ci; const bf16* gS = (const bf16*)(F.ws + WS_SB) + ci;
    const bf16* GL = (const bf16*)(F.ws + WS_GL) + (size_t)h * HD * RANK_G;
    BAR();
    bf16* mix = (bf16*)(F.ws + WS_MIX);
#pragma unroll 1
    for (int tt = 0; tt < 2; ++tt) {
        f32x16 y[2], g[2];
#pragma unroll
        for (int vt = 0; vt < 2; ++vt)
#pragma unroll
            for (int e = 0; e < 16; ++e) { y[vt][e] = 0.f; g[vt][e] = 0.f; }
#pragma unroll
        for (int s = 0; s < 4; ++s) {
            const bf16x8 bb = *(const GAS bf16x8*)(gRW + (size_t)(tt * 32 + r) * 64 + s * 16 + hh * 8);
#pragma unroll
            for (int vt = 0; vt < 2; ++vt) { const bf16x8 a = *(const GAS bf16x8*)(gS + (size_t)(vt * 32 + r) * 64 + s * 16 + hh * 8); y[vt] = MFMA32(a, bb, y[vt]); }
        }
#pragma unroll
        for (int s = 0; s < 10; ++s) {
            const bf16x8 bb = *(const LAS bf16x8*)(XG + (tt * 32 + r) * GLD + s * 16 + hh * 8);
#pragma unroll
            for (int vt = 0; vt < 2; ++vt) { const bf16x8 a = *(const GAS bf16x8*)(GL + (size_t)(vt * 32 + r) * RANK_G + s * 16 + hh * 8); g[vt] = MFMA32(a, bb, g[vt]); }
        }
        const int t = tt * 32 + r, tau = c * CH + t; const size_t row = (size_t)b * T + tau; const bool hp = tau > 0;
        float sum = 0.f;
#pragma unroll
        for (int vt = 0; vt < 2; ++vt)
#pragma unroll
            for (int q = 0; q < 4; ++q) { const v2u w = *(const GAS v2u*)(gYP + (size_t)t * 64 + vt * 32 + q * 8 + hh * 4);
                y[vt][4 * q + 0] += bflo(w.x); y[vt][4 * q + 1] += bfhi(w.x); y[vt][4 * q + 2] += bflo(w.y); y[vt][4 * q + 3] += bfhi(w.y);
                sum += (y[vt][4 * q + 0] + y[vt][4 * q + 1]) + (y[vt][4 * q + 2] + y[vt][4 * q + 3]); }
        sum += __shfl_xor(sum, 32);
        const float mean = sum * (1.f / 64.f); float sq = 0.f;
#pragma unroll
        for (int vt = 0; vt < 2; ++vt)
#pragma unroll
            for (int e = 0; e < 16; ++e) { const float d = y[vt][e] - mean; sq += d * d; }
        sq += __shfl_xor(sq, 32);
        const float rstd = rsqrtf(sq * (1.f / 64.f) + GN_EPS);
        const float cb = ((const float*)(F.ws + WS_CB))[row * NH + h];
#pragma unroll
        for (int vt = 0; vt < 2; ++vt)
#pragma unroll
            for (int q = 0; q < 4; ++q) { const int v0 = vt * 32 + q * 8 + hh * 4, col = C_V + h * HD + v0;
                const v2u cw = *(const GAS v2u*)(proj + row * PROJ_LD + col); v2u pw = *(const GAS v2u*)(proj + (row - (hp ? 1 : 0)) * PROJ_LD + col); if (!hp) pw = (v2u){0u, 0u};
                const f32x4 mu = *(const GAS f32x4*)(F.shift_mu + (col - CONV_COLS)), lg = *(const GAS f32x4*)(F.ln_x_g + h * HD + v0), lb = *(const GAS f32x4*)(F.ln_x_b + h * HD + v0);
                const float cu[4] = {bflo(cw.x), bfhi(cw.x), bflo(cw.y), bfhi(cw.y)}, pr[4] = {bflo(pw.x), bfhi(pw.x), bflo(pw.y), bfhi(pw.y)};
                float o[4];
#pragma unroll
                for (int e = 0; e < 4; ++e) { const float vv = cu[e] + mu[e] * (pr[e] - cu[e]); o[e] = ((y[vt][4 * q + e] - mean) * rstd * lg[e] + lb[e] + cb * vv) * g[vt][4 * q + e]; }
                v2u ow; ow.x = pk2(o[0], o[1]); ow.y = pk2(o[2], o[3]);
                *(GAS v2u*)(mix + row * D + CONVD + h * HD + v0) = ow; }
    }
    BAR();
}
constexpr int VLD = 520, OUT_VS = 3 * SLOT, OUT_LNG = OUT_VS + 64 * VLD * 2, OUT_LNB = OUT_LNG + 2048, OUT_CBS = OUT_LNB + 2048;
static_assert(OUT_CBS + 2048 <= LDSCTL_OFF, "output-phase LDS map");
DI void rw_out_chunk2(Frame& F, int b, int c) {
    const bf16* proj = (const bf16*)(F.ws + WS_PROJ);
    LAS bf16* XG = slotp(F, 0); LAS bf16* VS = (LAS bf16*)(F.lds + OUT_VS); LAS float* LNG = (LAS float*)(F.lds + OUT_LNG); LAS float* LNB = (LAS float*)(F.lds + OUT_LNB); LAS float* CBS = (LAS float*)(F.lds + OUT_CBS);
    {   const int t = F.tid >> 3, cg = F.tid & 7, tau = c * CH + t; const size_t row = (size_t)b * T + tau, prow = row - (tau > 0 ? 1 : 0); const bool hp = tau > 0;
        {   const float lgv = F.ln_x_g[F.tid], lbv = F.ln_x_b[F.tid], cbv = ((const float*)(F.ws + WS_CB))[((size_t)b * T + c * CH) * NH + F.tid];
            v4u xc[3], xp[3]; f32x4 xm0[3], xm1[3];
#pragma unroll
            for (int q = 0; q < 3; ++q) { const int g8 = (cg + 8 * q < RANK_G / 8) ? cg + 8 * q : cg; xc[q] = *(const GAS v4u*)(proj + row * PROJ_LD + C_XG + g8 * 8); xp[q] = *(const GAS v4u*)(proj + prow * PROJ_LD + C_XG + g8 * 8);
                xm0[q] = *(const GAS f32x4*)(F.shift_mu + (C_XG - CONV_COLS) + g8 * 8); xm1[q] = *(const GAS f32x4*)(F.shift_mu + (C_XG - CONV_COLS) + g8 * 8 + 4); }
#pragma unroll
            for (int q = 0; q < 3; ++q) { const int g8 = cg + 8 * q; if (g8 < RANK_G / 8) { float cu[8], pr[8], o[8]; unpack8(xc[q], cu); unpack8(xp[q], pr);
                const float mu[8] = {xm0[q][0], xm0[q][1], xm0[q][2], xm0[q][3], xm1[q][0], xm1[q][1], xm1[q][2], xm1[q][3]};
#pragma unroll
                for (int j = 0; j < 8; ++j) { const float pv = hp ? pr[j] : 0.f; o[j] = fsigmoid(cu[j] + mu[j] * (pv - cu[j])); }
                *(LAS v4u*)(XG + t * GLD + g8 * 8) = pack8(o); } }
            LNG[F.tid] = lgv; LNB[F.tid] = lbv; CBS[F.tid] = cbv;
        }
#pragma unroll 1
        for (int half = 0; half < 2; ++half) {
            v4u vc[4], vp[4]; f32x4 m0[4], m1[4];
#pragma unroll
            for (int i = 0; i < 4; ++i) { const int col = (cg + 8 * (4 * half + i)) * 8; vc[i] = *(const GAS v4u*)(proj + row * PROJ_LD + C_V + col); vp[i] = *(const GAS v4u*)(proj + prow * PROJ_LD + C_V + col);
                m0[i] = *(const GAS f32x4*)(F.shift_mu + 2 * RWD + col); m1[i] = *(const GAS f32x4*)(F.shift_mu + 2 * RWD + col + 4); }
#pragma unroll
            for (int i = 0; i < 4; ++i) { const int col = (cg + 8 * (4 * half + i)) * 8; float cu[8], pr[8], o[8]; unpack8(vc[i], cu); unpack8(vp[i], pr);
                const float mu[8] = {m0[i][0], m0[i][1], m0[i][2], m0[i][3], m1[i][0], m1[i][1], m1[i][2], m1[i][3]};
#pragma unroll
                for (int j = 0; j < 8; ++j) { const float pv = hp ? pr[j] : 0.f; o[j] = cu[j] + mu[j] * (pv - cu[j]); }
                *(LAS v4u*)(VS + t * VLD + col) = pack8(o); }
        }
    }
    const int h = F.wave, r = F.lane & 31, hh = F.lane >> 5;
    const size_t ci = ((size_t)(b * NH + h) * NCH + c) * CHUNK_ELEMS;
    const bf16* gRW = chunk_RW(F) + ci; const bf16* gYP = chunk_YP(F) + ci; const bf16* gS = (const bf16*)(F.ws + WS_SB) + ci;
    const bf16* GL = (const bf16*)(F.ws + WS_GL) + (size_t)h * HD * RANK_G;
    bf16* mix = (bf16*)(F.ws + WS_MIX);
    BAR();
    unsigned gp[2][2][8];
    {   f32x16 g[2][2];
#pragma unroll
        for (int vt = 0; vt < 2; ++vt)
#pragma unroll
            for (int tt = 0; tt < 2; ++tt) g[vt][tt] = zero16();
#pragma unroll 1
        for (int kh = 0; kh < 2; ++kh) {
            bf16x8 ga[2][5];
#pragma unroll
            for (int vt = 0; vt < 2; ++vt)
#pragma unroll
                for (int s = 0; s < 5; ++s) ga[vt][s] = *(const GAS bf16x8*)(GL + (size_t)(vt * 32 + r) * RANK_G + (kh * 5 + s) * 16 + hh * 8);
#pragma unroll
            for (int s = 0; s < 5; ++s)
#pragma unroll
                for (int tt = 0; tt < 2; ++tt) { const bf16x8 bb = *(const LAS bf16x8*)(XG + (tt * 32 + r) * GLD + (kh * 5 + s) * 16 + hh * 8);
#pragma unroll
                    for (int vt = 0; vt < 2; ++vt) g[vt][tt] = MFMA32(ga[vt][s], bb, g[vt][tt]); }
        }
#pragma unroll
        for (int vt = 0; vt < 2; ++vt)
#pragma unroll
            for (int tt = 0; tt < 2; ++tt)
#pragma unroll
                for (int e = 0; e < 8; ++e) gp[vt][tt][e] = pk2(g[vt][tt][2 * e], g[vt][tt][2 * e + 1]);
    }
#pragma unroll
    for (int tt = 0; tt < 2; ++tt) {
        __builtin_amdgcn_sched_barrier(0);
        const int t = tt * 32 + r; const size_t row = (size_t)b * T + c * CH + t;
        const bf16* gRWl = gRW; const bf16* gYPl = gYP; const bf16* gSl = gS; asm volatile("" : "+s"(gRWl), "+s"(gYPl), "+s"(gSl));
        int hl = h; asm volatile("" : "+s"(hl));
        bf16x8 rb[4]; v2u ypw[2][4]; bf16x8 sa[2][4];
#pragma unroll
        for (int vt = 0; vt < 2; ++vt)
#pragma unroll
            for (int s = 0; s < 4; ++s) sa[vt][s] = *(const GAS bf16x8*)(gSl + (size_t)(vt * 32 + r) * 64 + s * 16 + hh * 8);
#pragma unroll
        for (int s = 0; s < 4; ++s) rb[s] = *(const GAS bf16x8*)(gRWl + (size_t)t * 64 + s * 16 + hh * 8);
#pragma unroll
        for (int vt = 0; vt < 2; ++vt)
#pragma unroll
            for (int q = 0; q < 4; ++q) ypw[vt][q] = *(const GAS v2u*)(gYPl + (size_t)t * 64 + vt * 32 + q * 8 + hh * 4);
        f32x16 y[2];
#pragma unroll
        for (int vt = 0; vt < 2; ++vt) y[vt] = zero16();
#pragma unroll
        for (int s = 0; s < 4; ++s)
#pragma unroll
            for (int vt = 0; vt < 2; ++vt) y[vt] = MFMA32(sa[vt][s], rb[s], y[vt]);
        float sum = 0.f;
#pragma unroll
        for (int vt = 0; vt < 2; ++vt)
#pragma unroll
            for (int q = 0; q < 4; ++q) { const v2u w = ypw[vt][q];
                y[vt][4 * q + 0] += bflo(w.x); y[vt][4 * q + 1] += bfhi(w.x); y[vt][4 * q + 2] += bflo(w.y); y[vt][4 * q + 3] += bfhi(w.y);
                sum += (y[vt][4 * q + 0] + y[vt][4 * q + 1]) + (y[vt][4 * q + 2] + y[vt][4 * q + 3]); }
        sum += __shfl_xor(sum, 32);
        const float mean = sum * (1.f / 64.f); float sq = 0.f;
#pragma unroll
        for (int vt = 0; vt < 2; ++vt)
#pragma unroll
            for (int e = 0; e < 16; ++e) { const float d = y[vt][e] - mean; sq += d * d; }
        sq += __shfl_xor(sq, 32);
        const float rstd = rsqrtf(sq * (1.f / 64.f) + GN_EPS);
        const float cb = CBS[t * NH + hl];
#pragma unroll
        for (int vt = 0; vt < 2; ++vt)
#pragma unroll
            for (int q = 0; q < 4; ++q) { const int v0 = vt * 32 + q * 8 + hh * 4;
                const v2u vw = *(const LAS v2u*)(VS + t * VLD + hl * HD + v0); const f32x4 lg = *(const LAS f32x4*)(LNG + hl * HD + v0), lb = *(const LAS f32x4*)(LNB + hl * HD + v0);
                const float vv[4] = {bflo(vw.x), bfhi(vw.x), bflo(vw.y), bfhi(vw.y)};
                const float gg[4] = {bflo(gp[vt][tt][2 * q]), bfhi(gp[vt][tt][2 * q]), bflo(gp[vt][tt][2 * q + 1]), bfhi(gp[vt][tt][2 * q + 1])};
                float o[4];
#pragma unroll
                for (int e = 0; e < 4; ++e) o[e] = ((y[vt][4 * q + e] - mean) * rstd * lg[e] + lb[e] + cb * vv[e]) * gg[e];
                v2u ow; ow.x = pk2(o[0], o[1]); ow.y = pk2(o[2], o[3]);
                *(GAS v2u*)(mix + row * D + CONVD + hl * HD + v0) = ow; }
    }
    BAR();
}
#ifndef MK_SKIP2
#define MK_SKIP2 0
#endif
#ifndef MK_SKIP4
#define MK_SKIP4 0
#endif
#ifndef MK_XIT
#define MK_XIT 0
#endif
#ifndef MK_XM5
#define MK_XM5 0
#endif
#ifndef MK_DUP
#define MK_DUP -1
#endif
constexpr int NPH = 10;
struct Args { const float* in[24]; float* out; unsigned char* ws; int ph_lo, ph_hi, li, pad; };
__global__ void __launch_bounds__(NWAVES * 64, 2) mk_fwd(Args args) {
    extern __shared__ __attribute__((aligned(16))) unsigned char lds[];
    Frame F;
    F.lds = (LAS unsigned char*)lds;
    F.MISC = (volatile LAS unsigned*)(F.lds + LDSCTL_OFF);
    F.tid = threadIdx.x; F.lane = F.tid & 63; F.wave = __builtin_amdgcn_readfirstlane(F.tid >> 6);
    F.G = gridDim.x; { const int bx = blockIdx.x; F.vcu = (F.G % 8 == 0) ? (bx % 8) * (F.G / 8) + bx / 8 : bx; }
    F.ws = args.ws; F.ctl = (gu32*)(args.ws + WS_CTL); F.out = args.out;
    F.x = args.in[0]; F.p = args.in[1]; F.norm_mix_g = args.in[2]; F.w_in = args.in[3]; F.conv_w = args.in[4]; F.shift_mu = args.in[5]; F.w_lora_up = args.in[6]; F.w0 = args.in[7];
    F.a_lora_up = args.in[8]; F.a0 = args.in[9]; F.g_lora_up = args.in[10]; F.k_k = args.in[11]; F.k_a = args.in[12]; F.r_k = args.in[13]; F.ln_x_g = args.in[14]; F.ln_x_b = args.in[15];
    F.w_out = args.in[16]; F.norm_mlp_g = args.in[17]; F.w_up = args.in[18]; F.w_down = args.in[19]; F.norm_ple_g = args.in[20]; F.w_ple_gate = args.in[21]; F.w_ple_proj = args.in[22]; F.norm_final_g = args.in[23];
    for (int u = F.tid; u < (LDS_BYTES - LDSCTL_OFF) / 4; u += NWAVES * 64) ((LAS unsigned*)(F.lds + LDSCTL_OFF))[u] = 0u;
    __syncthreads();
    XcdBarrier bar; bar.bar = (unsigned*)(F.ctl + CW_BAR) + args.li * XCD_BAR_WORDS; bar.x = 0; bar.st = nullptr;
    if (N_LAUNCHES == 1) bar = xcd_barrier_post((unsigned*)(F.ctl + CW_BAR), F.MISC + 8);
    const int lo = args.ph_lo, hi = args.ph_hi;
#define IN(k) (lo <= (k) && (k) < hi)
#define SEAM(k) do { if (IN(k) && IN((k) + 1)) xcd_barrier(bar); } while (0)
    bf16* ABUF = (bf16*)(F.ws + WS_ABUF); bf16* PROJ = (bf16*)(F.ws + WS_PROJ); bf16* MIX = (bf16*)(F.ws + WS_MIX); bf16* PLEB = (bf16*)(F.ws + WS_PLE); bf16* HSQ = (bf16*)(F.ws + WS_HSQ); bf16* PB = (bf16*)(F.ws + WS_PB);
    float* SSQ1 = (float*)(F.ws + WS_SSQ1); float* SSQ2 = (float*)(F.ws + WS_SSQ2); float* SSQ3 = (float*)(F.ws + WS_SSQ3);

    if (IN(0)) for (int rep = 0; rep < (MK_DUP == 0 ? 2 : 1); ++rep) { p0_prologue(F); } SEAM(0);
    if (IN(1)) for (int rep = 0; rep < (MK_DUP == 1 ? 2 : 1); ++rep) {
        { pg8::Gemm g{ABUF, (const bf16*)(F.ws + WS_WIN), M, IN_PAD, D}; pg8::StaticOrder S; S.init(M, IN_PAD, F.G, (int)blockIdx.x);
          pg8::EpiBf16G E{PROJ, PROJ_LD, IN_COLS};
          pg8::gemm_phase<pg8::EpiBf16G, pg8::StaticOrder, PG8_ALIGN, PG8_SP2>(F.lds, g, S, E); }
        { pg8::Gemm g{PB, (const bf16*)(F.ws + WS_WPLE), M, D, PLE}; pg8::StaticOrder S; S.init(M, D, F.G, (int)blockIdx.x);
          pg8::EpiBf16G E{PLEB, D, D};
          pg8::gemm_phase<pg8::EpiBf16G, pg8::StaticOrder, PG8_ALIGN, PG8_SP2>(F.lds, g, S, E); }
    } SEAM(1);
#if MK_NAIVE
    if (IN(2)) {
        if (F.vcu < BATCH * NH) rwkv_naive_chain(F, F.vcu);
        else conv_wave(F, (F.vcu - BATCH * NH) * NWAVES + F.wave, (F.G - BATCH * NH) * NWAVES);
    } SEAM(2); SEAM(3); SEAM(4);
#else
    if (IN(2)) for (int rep = 0; rep < (MK_DUP == 2 ? 2 : 1); ++rep) { const int bc = F.vcu; if (bc < BATCH * NCH && !MK_SKIP2) rw_chunk_wg3(F, bc / NCH, bc % NCH); } SEAM(2);
    if (IN(3)) for (int rep = 0; rep < (MK_DUP == 3 ? 2 : 1); ++rep) {
        constexpr int NTASK = BATCH * NH * 4;
        if (F.vcu < NTASK && F.wave == 0) rw_scan_task(F, F.vcu);
        else { const int cw = F.vcu < NTASK ? F.vcu * (NWAVES - 1) + F.wave - 1 : NTASK * (NWAVES - 1) + (F.vcu - NTASK) * NWAVES + F.wave, ncw = F.G * NWAVES - NTASK;
            conv_wave(F, cw, ncw);
            if (MK_LATEW) convert_weights(F, 1, (LAS float*)(F.lds + SC_D * SC_SLOT + F.wave * 8448), cw, ncw); }
    } SEAM(3);
    if (IN(4)) for (int rep = 0; rep < (MK_DUP == 4 ? 2 : 1); ++rep) { const int bc = F.vcu; if (bc < BATCH * NCH && !MK_SKIP4) rw_out_chunk2(F, bc / NCH, bc % NCH); } SEAM(4);
#endif
    if (IN(5)) for (int rep = 0; rep < (MK_DUP == 5 ? 2 : 1); ++rep) {
        pg8::Gemm g{MIX, (const bf16*)(F.ws + WS_WOUT), M, D, D}; pg8::StaticOrder S; S.init(M, D, F.G, (int)blockIdx.x);
        pg8::EpiRes E{F.x, F.out, ABUF, SSQ1, D};
        pg8::gemm_phase<pg8::EpiRes, pg8::StaticOrder, false, PG8_SP2>(F.lds, g, S, E);
    } SEAM(5);
    if (IN(6)) for (int rep = 0; rep < (MK_DUP == 6 ? 2 : 1); ++rep) {
        pg8::Gemm g{ABUF, (const bf16*)(F.ws + WS_WUP), M, FF, D}; pg8::StaticOrder S; S.init(M, FF, F.G, (int)blockIdx.x);
        pg8::EpiSqRelu E{HSQ, FF, SSQ1, 1.f / D, RMS_EPS};
        pg8::gemm_phase<pg8::EpiSqRelu, pg8::StaticOrder, PG8_ALIGN, PG8_SP2>(F.lds, g, S, E);
    } SEAM(6);
    if (IN(7)) {
        pg8::Gemm g{HSQ, (const bf16*)(F.ws + WS_WDN), M, D, FF}; pg8::StaticOrder S; S.init(M, D, F.G, (int)blockIdx.x);
        pg8::EpiRes E{F.out, F.out, ABUF, SSQ2, D};
        pg8::gemm_phase<pg8::EpiRes, pg8::StaticOrder, false, PG8_SP2>(F.lds, g, S, E);
    } SEAM(7);
    if (IN(8)) {
        pg8::Gemm g{ABUF, (const bf16*)(F.ws + WS_WG), M, D, D}; pg8::StaticOrder S; S.init(M, D, F.G, (int)blockIdx.x);
        pg8::EpiGate E{F.out, PLEB, SSQ2, SSQ3, D, 1.f / D, RMS_EPS};
        pg8::gemm_phase<pg8::EpiGate, pg8::StaticOrder, false, PG8_SP2>(F.lds, g, S, E);
    } SEAM(8);
    if (IN(9)) { final_norm(F); }
#undef IN
#undef SEAM
}

extern "C" void kernel_launch(void* const* d_in, const int* in_sizes, int n_in, void* d_out, int out_size, void* d_ws, size_t ws_size, hipStream_t stream) {
    static int grid = 0;
    if (grid == 0) {
        if (n_in != 24 || in_sizes[0] != M * D || out_size != M * D || ws_size < WS_END) { fprintf(stderr, "kernel_launch: unexpected shapes: n_in %d in0 %d out %d ws %zu\n", n_in, n_in > 0 ? in_sizes[0] : -1, out_size, ws_size); grid = -1; return; }
        int dev = 0, cus = 0, per_cu = 0;
        if (hipGetDevice(&dev) != hipSuccess || hipDeviceGetAttribute(&cus, hipDeviceAttributeMultiprocessorCount, dev) != hipSuccess) { fprintf(stderr, "kernel_launch: device query failed\n"); grid = -1; return; }
        if (hipFuncSetAttribute((const void*)mk_fwd, hipFuncAttributeMaxDynamicSharedMemorySize, LDS_BYTES) != hipSuccess) { fprintf(stderr, "kernel_launch: hipFuncSetAttribute failed\n"); grid = -1; return; }
        if (hipOccupancyMaxActiveBlocksPerMultiprocessor(&per_cu, (const void*)mk_fwd, NWAVES * 64, LDS_BYTES) != hipSuccess || per_cu < 1)
            fprintf(stderr, "kernel_launch: note: occupancy query reports %d workgroups per CU\n", per_cu);
        (void)hipGetLastError();
        grid = cus;
        if (grid != 256) { fprintf(stderr, "kernel_launch: this kernel needs a 256-CU device (got %d)\n", grid); grid = -1; return; }
    }
    if (grid < 0) return;
    if (hipMemsetAsync((char*)d_ws + WS_CTL, 0, CTL_ZERO_BYTES, stream) != hipSuccess) { fprintf(stderr, "kernel_launch: hipMemsetAsync failed\n"); return; }
    Args a{};
    for (int i = 0; i < 24; ++i) a.in[i] = (const float*)d_in[i];
    a.out = (float*)d_out; a.ws = (unsigned char*)d_ws;
    if (N_LAUNCHES == 1) { a.ph_lo = 0; a.ph_hi = NPH; a.li = 0; hipLaunchKernelGGL(mk_fwd, dim3(grid), dim3(NWAVES * 64), LDS_BYTES, stream, a); }
    else for (int li = 0; li < NPH; ++li) { a.ph_lo = li; a.ph_hi = li + 1; a.li = 0; hipLaunchKernelGGL(mk_fwd, dim3(grid), dim3(NWAVES * 64), LDS_BYTES, stream, a); }
    const hipError_t le = hipPeekAtLastError();
    if (le != hipSuccess) fprintf(stderr, "kernel_launch: launch failed: %s\n", hipGetErrorName(le));
}
```
